# Optimizing an MI355X kernel written in HIP

```python
import math
import jax, jax.numpy as jnp
from jax import lax
import numpy as np

D_MODEL = 4096
BATCH = 1
SEQ = 8192
DEPTH = 1

HEAD_DIM = 128
DIFF_V_DIM = 2 * HEAD_DIM
DIFF_HEADS = (D_MODEL // 2) // DIFF_V_DIM
DIFF_WIDTH = DIFF_HEADS * DIFF_V_DIM
NSA_HEADS = (D_MODEL - DIFF_WIDTH) // HEAD_DIM
NSA_KV_HEADS = 4
NSA_GROUP = NSA_HEADS // NSA_KV_HEADS
NSA_WIDTH = NSA_HEADS * HEAD_DIM
CMP_BLOCK = 32
CMP_STRIDE = 16
CMP_HIDDEN = 256
SEL_BLOCK = 64
SEL_TOPN = 16
WINDOW = 512
Q_BLOCK = 128
D_FF = 11008
EPS = 1e-6
NEG = -1e30
FORCE_SCORE = 1e4

SPLIT_SIZES = [
    DIFF_HEADS * 2 * HEAD_DIM,
    DIFF_HEADS * 2 * HEAD_DIM,
    DIFF_HEADS * DIFF_V_DIM,
    NSA_HEADS * HEAD_DIM,
    NSA_KV_HEADS * HEAD_DIM,
    NSA_KV_HEADS * HEAD_DIM,
    NSA_KV_HEADS * HEAD_DIM,
    NSA_KV_HEADS * HEAD_DIM,
    NSA_KV_HEADS * HEAD_DIM,
    NSA_KV_HEADS * HEAD_DIM,
    3 * NSA_HEADS,
]
N_IN = sum(SPLIT_SIZES)

kernel_name = "hybrid_diff_nsa_macaron_alibi"


def rmsnorm(x, g):
    x32 = x.astype(jnp.float32)
    y = x32 * lax.rsqrt(jnp.mean(x32 * x32, axis=-1, keepdims=True) + EPS)
    return (y * g.astype(jnp.float32)).astype(x.dtype)


def swiglu(x, w_gate, w_up, w_down):
    return (jax.nn.silu(x @ w_gate) * (x @ w_up)) @ w_down


def alibi_slopes(n):
    return 2.0 ** (-8.0 * jnp.arange(1, n + 1, dtype=jnp.float32) / n)


def lambda_init(layer):
    return 0.8 - 0.6 * math.exp(-0.3 * layer)


def diff_attention(q, k, v, lam, slopes):
    B, S, H, _, Dh = q.shape
    scale = Dh ** -0.5
    kpos = jnp.arange(S)

    def block(i):
        s0 = i * Q_BLOCK
        qb = lax.dynamic_slice_in_dim(q, s0, Q_BLOCK, axis=1)
        dist = (s0 + jnp.arange(Q_BLOCK))[:, None] - kpos[None, :]
        bias = -slopes[:, None, None, None] * dist
        s = jnp.einsum('bqhmd,bkhmd->bhmqk', qb, k) * scale + bias
        p = jax.nn.softmax(jnp.where(dist >= 0, s, NEG), axis=-1)
        a = p[:, :, 0] - lam * p[:, :, 1]
        return jnp.einsum('bhqk,bkhe->bqhe', a, v)

    o = lax.map(block, jnp.arange(S // Q_BLOCK))
    return jnp.moveaxis(o, 0, 1).reshape(B, S, H, -1)


def compress(kv, pos, w1, w2):
    B, S, Hkv, Dh = kv.shape
    n_cmp = (S - CMP_BLOCK) // CMP_STRIDE + 1
    idx = jnp.arange(n_cmp)[:, None] * CMP_STRIDE + jnp.arange(CMP_BLOCK)[None, :]
    blocks = kv[:, idx] + pos[:, None, :]
    blocks = blocks.transpose(0, 1, 3, 2, 4).reshape(B, n_cmp, Hkv, CMP_BLOCK * Dh)
    return jax.nn.gelu(blocks @ w1) @ w2


def native_sparse_attention(q, k_cmp, v_cmp, k_sel, v_sel, k_win, v_win, gates,
                            pos_k, w1_k, w2_k, pos_v, w1_v, w2_v, slopes):
    B, S, Hkv, G, Dh = q.shape
    scale = Dh ** -0.5
    kc = compress(k_cmp, pos_k, w1_k, w2_k)
    vc = compress(v_cmp, pos_v, w1_v, w2_v)
    n_cmp = kc.shape[1]
    cmp_start = jnp.arange(n_cmp) * CMP_STRIDE
    cmp_end = cmp_start + CMP_BLOCK - 1
    n_sel = S // SEL_BLOCK
    topn = min(SEL_TOPN, n_sel)
    sel_start = jnp.arange(n_sel) * SEL_BLOCK
    overlap = ((cmp_start[:, None] <= sel_start[None, :] + SEL_BLOCK - 1)
               & (cmp_end[:, None] >= sel_start[None, :])).astype(jnp.float32)
    ks_t = k_sel.reshape(B, n_sel, SEL_BLOCK, Hkv, Dh).transpose(0, 3, 1, 2, 4)
    vs_t = v_sel.reshape(B, n_sel, SEL_BLOCK, Hkv, Dh).transpose(0, 3, 1, 2, 4)
    bi = jnp.arange(B)[:, None, None, None]
    hi = jnp.arange(Hkv)[None, :, None, None]
    pad = ((0, 0), (WINDOW, 0), (0, 0), (0, 0))
    kw_pad = jnp.pad(k_win, pad)
    vw_pad = jnp.pad(v_win, pad)
    sl = slopes[:, :, None, None]
    blk_ids = jnp.arange(n_sel)

    def block(i):
        s0 = i * Q_BLOCK
        t = s0 + jnp.arange(Q_BLOCK)
        qb = lax.dynamic_slice_in_dim(q, s0, Q_BLOCK, axis=1)
        gb = lax.dynamic_slice_in_dim(gates, s0, Q_BLOCK, axis=1)
        dist_c = t[:, None] - cmp_end[None, :]
        ok_c = dist_c >= 0
        s_c = jnp.einsum('bqhgd,bchd->bhgqc', qb, kc) * scale - sl * dist_c
        p_c = jax.nn.softmax(jnp.where(ok_c, s_c, NEG), axis=-1) * ok_c
        o_c = jnp.einsum('bhgqc,bchd->bqhgd', p_c, vc)
        imp = jnp.einsum('bhgqc,cn->bhqn', p_c, overlap)
        cur = t // SEL_BLOCK
        valid = blk_ids[None, :] <= cur[:, None]
        forced = ((blk_ids[None, :] == 0) | (blk_ids[None, :] == cur[:, None])
                  | (blk_ids[None, :] == cur[:, None] - 1))
        score = jnp.where(forced, FORCE_SCORE, jnp.where(valid, imp, -1.0))
        _, sel = lax.top_k(score, topn)
        kg = ks_t[bi, hi, sel].reshape(B, Hkv, Q_BLOCK, topn * SEL_BLOCK, Dh)
        vg = vs_t[bi, hi, sel].reshape(B, Hkv, Q_BLOCK, topn * SEL_BLOCK, Dh)
        pos_s = sel[..., None] * SEL_BLOCK + jnp.arange(SEL_BLOCK)
        dist_s = (t[:, None, None] - pos_s).reshape(B, Hkv, 1, Q_BLOCK, topn * SEL_BLOCK)
        s_s = jnp.einsum('bqhgd,bhqmd->bhgqm', qb, kg) * scale - sl * dist_s
        p_s = jax.nn.softmax(jnp.where(dist_s >= 0, s_s, NEG), axis=-1)
        o_s = jnp.einsum('bhgqm,bhqmd->bqhgd', p_s, vg)
        kw = lax.dynamic_slice_in_dim(kw_pad, s0, WINDOW + Q_BLOCK, axis=1)
        vw = lax.dynamic_slice_in_dim(vw_pad, s0, WINDOW + Q_BLOCK, axis=1)
        kpos = s0 - WINDOW + jnp.arange(WINDOW + Q_BLOCK)
        dist_w = t[:, None] - kpos[None, :]
        ok_w = (dist_w >= 0) & (dist_w < WINDOW) & (kpos[None, :] >= 0)
        s_w = jnp.einsum('bqhgd,bkhd->bhgqk', qb, kw) * scale - sl * dist_w
        p_w = jax.nn.softmax(jnp.where(ok_w, s_w, NEG), axis=-1)
        o_w = jnp.einsum('bhgqk,bkhd->bqhgd', p_w, vw)
        return gb[..., 0:1] * o_c + gb[..., 1:2] * o_s + gb[..., 2:3] * o_w

    o = lax.map(block, jnp.arange(S // Q_BLOCK))
    return jnp.moveaxis(o, 0, 1).reshape(B, S, Hkv * G * Dh)


def setup_inputs(seed: int = 0) -> dict:
    key = jax.random.key(seed)
    ks = jax.random.split(key, 32)

    def nrm(k, shape, scale):
        return jax.random.normal(k, shape, jnp.float32) * scale

    def gain(k, shape):
        return 1.0 + 0.05 * jax.random.normal(k, shape, jnp.float32)

    L, D = DEPTH, D_MODEL
    cin = CMP_BLOCK * HEAD_DIM
    return {
        "x": nrm(ks[0], (BATCH, SEQ, D), 1.0),
        "ffn1_norm": gain(ks[1], (L, D)),
        "ffn1_w_gate": nrm(ks[2], (L, D, D_FF), D ** -0.5),
        "ffn1_w_up": nrm(ks[3], (L, D, D_FF), D ** -0.5),
        "ffn1_w_down": nrm(ks[4], (L, D_FF, D), D_FF ** -0.5),
        "mix_norm": gain(ks[5], (L, D)),
        "w_in": nrm(ks[6], (L, D, N_IN), D ** -0.5),
        "gate_bias": nrm(ks[7], (L, 3 * NSA_HEADS), 0.1),
        "lambda_q1": nrm(ks[8], (L, HEAD_DIM), 0.1),
        "lambda_k1": nrm(ks[9], (L, HEAD_DIM), 0.1),
        "lambda_q2": nrm(ks[10], (L, HEAD_DIM), 0.1),
        "lambda_k2": nrm(ks[11], (L, HEAD_DIM), 0.1),
        "diff_norm": gain(ks[12], (L, DIFF_V_DIM)),
        "cmp_pos_k": nrm(ks[13], (L, CMP_BLOCK, HEAD_DIM), 0.1),
        "cmp_w1_k": nrm(ks[14], (L, cin, CMP_HIDDEN), cin ** -0.5),
        "cmp_w2_k": nrm(ks[15], (L, CMP_HIDDEN, HEAD_DIM), CMP_HIDDEN ** -0.5),
        "cmp_pos_v": nrm(ks[16], (L, CMP_BLOCK, HEAD_DIM), 0.1),
        "cmp_w1_v": nrm(ks[17], (L, cin, CMP_HIDDEN), cin ** -0.5),
        "cmp_w2_v": nrm(ks[18], (L, CMP_HIDDEN, HEAD_DIM), CMP_HIDDEN ** -0.5),
        "w_out": nrm(ks[19], (L, D, D), D ** -0.5),
        "ffn2_norm": gain(ks[20], (L, D)),
        "ffn2_w_gate": nrm(ks[21], (L, D, D_FF), D ** -0.5),
        "ffn2_w_up": nrm(ks[22], (L, D, D_FF), D ** -0.5),
        "ffn2_w_down": nrm(ks[23], (L, D_FF, D), D_FF ** -0.5),
        "final_norm": gain(ks[24], (D,)),
    }


def reference(x, ffn1_norm, ffn1_w_gate, ffn1_w_up, ffn1_w_down, mix_norm, w_in, gate_bias,
              lambda_q1, lambda_k1, lambda_q2, lambda_k2, diff_norm,
              cmp_pos_k, cmp_w1_k, cmp_w2_k, cmp_pos_v, cmp_w1_v, cmp_w2_v,
              w_out, ffn2_norm, ffn2_w_gate, ffn2_w_up, ffn2_w_down, final_norm):
    B, S, _ = x.shape
    f32 = jnp.float32
    offsets = [int(o) for o in np.cumsum(SPLIT_SIZES)[:-1]]
    diff_slopes = alibi_slopes(DIFF_HEADS)
    nsa_slopes = alibi_slopes(NSA_HEADS).reshape(NSA_KV_HEADS, NSA_GROUP)
    kv_shape = (B, S, NSA_KV_HEADS, HEAD_DIM)
    h = x
    for l in range(DEPTH):
        h = h + 0.5 * swiglu(rmsnorm(h, ffn1_norm[l]), ffn1_w_gate[l], ffn1_w_up[l], ffn1_w_down[l])
        u = rmsnorm(h, mix_norm[l])
        proj = (u @ w_in[l]).astype(f32)
        dq, dk, dv, nq, kc, vc, ksl, vsl, kwn, vwn, g = jnp.split(proj, offsets, axis=-1)
        lam0 = lambda_init(l)
        lam = (jnp.exp(jnp.dot(lambda_q1[l].astype(f32), lambda_k1[l].astype(f32)))
               - jnp.exp(jnp.dot(lambda_q2[l].astype(f32), lambda_k2[l].astype(f32))) + lam0)
        o_diff = diff_attention(dq.reshape(B, S, DIFF_HEADS, 2, HEAD_DIM),
                                dk.reshape(B, S, DIFF_HEADS, 2, HEAD_DIM),
                                dv.reshape(B, S, DIFF_HEADS, DIFF_V_DIM), lam, diff_slopes)
        o_diff = rmsnorm(o_diff, diff_norm[l]) * (1.0 - lam0)
        gates = jax.nn.sigmoid(g + gate_bias[l].astype(f32)).reshape(B, S, NSA_KV_HEADS, NSA_GROUP, 3)
        o_nsa = native_sparse_attention(
            nq.reshape(B, S, NSA_KV_HEADS, NSA_GROUP, HEAD_DIM),
            kc.reshape(kv_shape), vc.reshape(kv_shape),
            ksl.reshape(kv_shape), vsl.reshape(kv_shape),
            kwn.reshape(kv_shape), vwn.reshape(kv_shape), gates,
            cmp_pos_k[l].astype(f32), cmp_w1_k[l].astype(f32), cmp_w2_k[l].astype(f32),
            cmp_pos_v[l].astype(f32), cmp_w1_v[l].astype(f32), cmp_w2_v[l].astype(f32),
            nsa_slopes)
        mix = jnp.concatenate([o_diff.reshape(B, S, DIFF_WIDTH), o_nsa], axis=-1).astype(h.dtype)
        h = h + mix @ w_out[l]
        h = h + 0.5 * swiglu(rmsnorm(h, ffn2_norm[l]), ffn2_w_gate[l], ffn2_w_up[l], ffn2_w_down[l])
    return rmsnorm(h, final_norm)
```

```cpp
#include <hip/hip_runtime.h>
#include <cstdio>
#include <cstdint>
#ifndef DBG_STAGE
#define DBG_STAGE 0
#endif
namespace pg8 {
#define PG8_LAS __attribute__((address_space(3)))
typedef unsigned short bf16_t;
typedef short bf16x8 __attribute__((ext_vector_type(8)));
typedef float f32x4 __attribute__((ext_vector_type(4)));
typedef unsigned u32x4 __attribute__((ext_vector_type(4)));
constexpr int BM = 256, BK = 64, HALF = 128, HTB = HALF * BK * 2  , STAGE_BYTES = 8 * HTB, NXCD = 8, WGM = 8;

__host__ __device__ __forceinline__ int lds_byte(int r, int c) { const int st = (r >> 4) * 2 + (c >> 5), rr = r & 15, cc = c & 31, ob = rr * 64 + cc * 2; return st * 1024 + (ob ^ (((ob >> 9) & 1) << 5)); }
__host__ __device__ __forceinline__ void stage_rc(int b, int& R, int& C) { const int st = b / 1024, sb = b % 1024, swz = sb ^ (((sb >> 9) & 1) << 5); R = (st >> 1) * 16 + swz / 64; C = (st & 1) * 32 + (swz % 64) / 2; }
__host__ __device__ __forceinline__ int perm32(int rho) { const int n = rho >> 4, i = rho & 15; return 8 * (i >> 2) + 4 * n + (i & 3); }

struct Unit { int pm, pn; };
struct Gemm { const bf16_t* A; const bf16_t* Bt; int M, N, K; int imgA = 0, imgB = 0; };

struct StaticOrder {
    int nM, nN, nwg, G, c;
    __host__ __device__ void init(int M, int N, int G_, int c_) { nM = M / BM; nN = N / BM; nwg = nM * nN; G = G_; c = c_; }
    __host__ __device__ bool next(int i, Unit& u) const {
        const long L = (long)i * G + c; if (L >= nwg) return false;
        int wgid = (int)L; { const int q = nwg / NXCD, r = nwg % NXCD, xcd = wgid % NXCD, off = wgid / NXCD; wgid = (xcd < r ? xcd * (q + 1) : r * (q + 1) + (xcd - r) * q) + off; }
        const int nig = WGM * nN, gid = wgid / nig, fm = gid * WGM, gsz = (nM - fm) < WGM ? (nM - fm) : WGM;
        u.pm = fm + ((wgid % nig) % gsz); u.pn = (wgid % nig) / gsz; return true;
    }
    __device__ __forceinline__ void a_ready(const Unit&) const {}
    __device__ __forceinline__ void done(const Unit&) const {}
};
typedef float f32x2c_t __attribute__((ext_vector_type(2))); typedef __bf16 bf16x2c_t __attribute__((ext_vector_type(2)));
__device__ __forceinline__ unsigned cvt_pk_bf16(float lo, float hi) { f32x2c_t v = {lo, hi}; bf16x2c_t b = __builtin_convertvector(v, bf16x2c_t); return __builtin_bit_cast(unsigned, b); }
typedef float f32x2 __attribute__((ext_vector_type(2)));
struct EpiSwiGLU {
    static constexpr bool PERM = true, AFTER_DRAIN = false;
    bf16_t* O; int ldc; int img;
    __device__ __forceinline__ void operator()(const f32x4 (&acc)[2][2][4][2], const Unit& u, int wr, int wc, int fr, int fq) const {
        const int row0 = u.pm * BM + wr * 64 + fr, col0 = u.pn * HALF + wc * 32 + 8 * fq;
        const int ntk = ldc >> 6;
#pragma unroll
        for (int ai = 0; ai < 2; ++ai)
#pragma unroll
            for (int m = 0; m < 4; ++m) { bf16_t* rowp = img ? (bf16_t*)((char*)O + ((size_t)(u.pm * 2 + ai) * ntk + (col0 >> 6)) * 16384 + lds_byte(wr * 64 + m * 16 + fr, col0 & 63))
                                                    : O + (size_t)(row0 + ai * HALF + m * 16) * ldc + col0;
                float v[8];
#pragma unroll
                for (int n = 0; n < 2; ++n)
#pragma unroll
                    for (int j = 0; j < 4; ++j) { const float g = acc[ai][0][m][n][j], up = acc[ai][1][m][n][j];
                        const float e = __builtin_amdgcn_exp2f(g * -1.4426950408889634f); v[4 * n + j] = g * __builtin_amdgcn_rcpf(1.0f + e) * up; }
                u32x4 w; w.x = cvt_pk_bf16(v[0], v[1]); w.y = cvt_pk_bf16(v[2], v[3]); w.z = cvt_pk_bf16(v[4], v[5]); w.w = cvt_pk_bf16(v[6], v[7]);
                *(u32x4*)rowp = w; }
    }
};
struct EpiResF32 {
    static constexpr bool PERM = false, AFTER_DRAIN = false;
    const float* base; float* out; int ldc; float alpha;
    __device__ __forceinline__ void operator()(const f32x4 (&acc)[2][2][4][2], const Unit& u, int wr, int wc, int fr, int fq) const {
        const int row0 = u.pm * BM + wr * 64 + fr, col0 = u.pn * BM + wc * 32 + 4 * fq;
#pragma unroll
        for (int ai = 0; ai < 2; ++ai)
#pragma unroll
            for (int m = 0; m < 4; ++m) { const size_t off = (size_t)(row0 + ai * HALF + m * 16) * ldc + col0;
#pragma unroll
                for (int bj = 0; bj < 2; ++bj)
#pragma unroll
                    for (int n = 0; n < 2; ++n) { const f32x4 b = *(const f32x4*)(base + off + bj * HALF + n * 16); *(f32x4*)(out + off + bj * HALF + n * 16) = b + acc[ai][bj][m][n] * alpha; }
                asm volatile("" ::: "memory"); }
    }
};
struct EpiProj {
    static constexpr bool PERM = true, AFTER_DRAIN = false;
    bf16_t* O; int ldc; int q0a, q0b, q1a, q1b; float qscale;
    __device__ __forceinline__ void operator()(const f32x4 (&acc)[2][2][4][2], const Unit& u, int wr, int wc, int fr, int fq) const {
        const int row0 = u.pm * BM + wr * 64 + fr, colt = u.pn * BM, col0 = colt + wc * 32 + 8 * fq;
        const float sc = ((colt >= q0a && colt < q0b) || (colt >= q1a && colt < q1b)) ? qscale : 1.0f;
#pragma unroll
        for (int ai = 0; ai < 2; ++ai)
#pragma unroll
            for (int m = 0; m < 4; ++m) { bf16_t* rowp = O + (size_t)(colt >> 7) * ((size_t)8192 * 128) + (size_t)(row0 + ai * HALF + m * 16) * 128 + wc * 32 + 8 * fq;
#pragma unroll
                for (int bj = 0; bj < 2; ++bj) { const f32x4 v0 = acc[ai][bj][m][0] * sc, v1 = acc[ai][bj][m][1] * sc;
                    u32x4 w; w.x = cvt_pk_bf16(v0[0], v0[1]); w.y = cvt_pk_bf16(v0[2], v0[3]); w.z = cvt_pk_bf16(v1[0], v1[1]); w.w = cvt_pk_bf16(v1[2], v1[3]);
                    *(u32x4*)(rowp + (size_t)bj * ((size_t)8192 * 128)) = w; } }
    }
};
template <class Epi, class Sched, bool ALIGN_EPI = false, bool SP2 = false>
__device__ __forceinline__ void gemm_phase(PG8_LAS unsigned char* lds, const Gemm g, const Sched& S, const Epi& E) {
    int tid_ = threadIdx.x; asm volatile("" : "+v"(tid_));
    const int tid = tid_, wid = __builtin_amdgcn_readfirstlane(tid >> 6), lane = tid & 63, wr = wid >> 2, wc = wid & 3, fr = lane & 15, fq = lane >> 4;
    const int K = g.K, nt = K / BK;
    unsigned voffA[2], voffB[2];
#pragma unroll
    for (int i = 0; i < 2; ++i) { int R, C; stage_rc(tid * 16 + i * 8192, R, C); const int Rb = Epi::PERM ? ((R & ~31) + perm32(R & 31)) : R;
        voffA[i] = g.imgA ? (unsigned)(tid * 16 + i * 8192) : (unsigned)(R * K + C) * 2u; voffB[i] = g.imgB ? (unsigned)(tid * 16 + i * 8192) : (unsigned)(Rb * K + C) * 2u; }
    const size_t kstA = g.imgA ? (size_t)HTB : (size_t)(BK * 2), kstB = g.imgB ? (size_t)HTB : (size_t)(BK * 2);
    const size_t hstA = g.imgA ? (size_t)HTB * nt : (size_t)HALF * K * 2, hstB = g.imgB ? (size_t)HTB * nt : (size_t)HALF * K * 2;
    const size_t tstA = 2 * hstA, tstB = 2 * hstB;
    const unsigned ldsw = (unsigned)wid * 1024u;
    const int aoff = lds_byte(wr * 64 + fr, fq * 8), boff = lds_byte(wc * 32 + fr, fq * 8);
#define PG8_SA(b, h) (((b) * 2 + (h)) * HTB)
#define PG8_SB(b, h) ((4 + (b) * 2 + (h)) * HTB)
#define PG8_STAGE(bufoff, gbase, voff) do { _Pragma("unroll") for (int _i = 0; _i < 2; ++_i) \
        __builtin_amdgcn_global_load_lds((const unsigned*)((const char*)(gbase) + (voff)[_i]), (PG8_LAS unsigned*)(lds + (bufoff) + ldsw + _i * 8192), 16, 0, 0); } while (0)
#define PG8_LDA(dst, b, h) do { _Pragma("unroll") for (int m = 0; m < 4; ++m) _Pragma("unroll") for (int k = 0; k < 2; ++k) dst[m][k] = *(const PG8_LAS bf16x8*)(lds + PG8_SA(b, h) + aoff + m * 2048 + k * 1024); } while (0)
#define PG8_LDB(dst, b, h) do { _Pragma("unroll") for (int n = 0; n < 2; ++n) _Pragma("unroll") for (int k = 0; k < 2; ++k) dst[n][k] = *(const PG8_LAS bf16x8*)(lds + PG8_SB(b, h) + boff + n * 2048 + k * 1024); } while (0)
#define PG8_MMA(ai, bj, At, Bt) do { __builtin_amdgcn_s_setprio(1); _Pragma("unroll") for (int m = 0; m < 4; ++m) _Pragma("unroll") for (int n = 0; n < 2; ++n) _Pragma("unroll") for (int k = 0; k < 2; ++k) \
        acc[ai][bj][m][n] = __builtin_amdgcn_mfma_f32_16x16x32_bf16(Bt[n][k], At[m][k], acc[ai][bj][m][n], 0, 0, 0); __builtin_amdgcn_s_setprio(0); } while (0)
#define PG8_WAIT_V(n) asm volatile("s_waitcnt vmcnt(" #n ")" ::: "memory")
#define PG8_WAIT_L(n) asm volatile("s_waitcnt lgkmcnt(" #n ")" ::: "memory")
#define PG8_BAR __builtin_amdgcn_s_barrier()
#define PG8_SCHED __builtin_amdgcn_sched_barrier(0)
    Unit cur, nxt; int ui = 0;
    if (!S.next(0, cur)) return;
    f32x4 acc[2][2][4][2];
#pragma unroll
    for (int a = 0; a < 2; ++a)
#pragma unroll
        for (int b = 0; b < 2; ++b)
#pragma unroll
            for (int m = 0; m < 4; ++m)
#pragma unroll
                for (int n = 0; n < 2; ++n) acc[a][b][m][n] = (f32x4){0.f, 0.f, 0.f, 0.f};
    bf16x8 At[4][2], B0[2][2], B1[2][2];
    const char* cA = (const char*)g.A + (size_t)cur.pm * tstA; const char* cB = (const char*)g.Bt + (size_t)cur.pn * tstB;
    S.a_ready(cur);
    if constexpr (SP2) {
        PG8_STAGE(PG8_SB(0, 0), cB, voffB); PG8_STAGE(PG8_SB(0, 1), cB + hstB, voffB); PG8_STAGE(PG8_SA(0, 0), cA, voffA); PG8_STAGE(PG8_SA(0, 1), cA + hstA, voffA);
        if (wr == 1) PG8_BAR;
        PG8_WAIT_V(2); PG8_BAR;
        PG8_STAGE(PG8_SB(1, 0), cB + kstB, voffB); PG8_STAGE(PG8_SA(1, 0), cA + kstA, voffA); PG8_STAGE(PG8_SB(1, 1), cB + hstB + kstB, voffB);
        PG8_WAIT_V(6); PG8_BAR;
    } else {
        PG8_STAGE(PG8_SB(0, 0), cB, voffB); PG8_STAGE(PG8_SA(0, 0), cA, voffA); PG8_STAGE(PG8_SB(0, 1), cB + hstB, voffB); PG8_STAGE(PG8_SA(0, 1), cA + hstA, voffA);
        if (wr == 1) PG8_BAR;
        PG8_WAIT_V(4); PG8_BAR;
        PG8_STAGE(PG8_SB(1, 0), cB + kstB, voffB); PG8_STAGE(PG8_SA(1, 0), cA + kstA, voffA); PG8_STAGE(PG8_SB(1, 1), cB + hstB + kstB, voffB);
        PG8_WAIT_V(6); PG8_BAR;
    }
    for (;;) {
        const bool has_next = S.next(ui + 1, nxt);
        const char* nA = has_next ? (const char*)g.A + (size_t)nxt.pm * tstA : cA; const char* nB = has_next ? (const char*)g.Bt + (size_t)nxt.pn * tstB : cB;
        for (int t = 0; t < nt; t += 2) {
            const bool last = (t == nt - 2);
            const char* a1 = cA + (size_t)(t + 1) * kstA;
            const char* a2 = last ? nA : cA + (size_t)(t + 2) * kstA; const char* b2 = last ? nB : cB + (size_t)(t + 2) * kstB;
            const char* a3 = a2 + kstA; const char* b3 = b2 + kstB;
            if (last && has_next) S.a_ready(nxt);
            if constexpr (SP2) {
            PG8_LDB(B0, 0, 0); PG8_LDB(B1, 0, 1); PG8_SCHED; PG8_LDA(At, 0, 0); PG8_STAGE(PG8_SA(1, 1), a1 + hstA, voffA);
            PG8_WAIT_V(8); PG8_WAIT_L(0); PG8_BAR; PG8_MMA(0, 0, At, B0); PG8_MMA(0, 1, At, B1); PG8_BAR; PG8_SCHED;
            PG8_LDA(At, 0, 1); PG8_STAGE(PG8_SB(0, 0), b2, voffB); PG8_STAGE(PG8_SB(0, 1), b2 + hstB, voffB); PG8_STAGE(PG8_SA(0, 0), a2, voffA);
            PG8_WAIT_V(8); PG8_WAIT_L(0); PG8_BAR; PG8_MMA(1, 0, At, B0); PG8_MMA(1, 1, At, B1); PG8_BAR; PG8_SCHED;
            PG8_LDB(B0, 1, 0); PG8_LDB(B1, 1, 1); PG8_SCHED; PG8_LDA(At, 1, 0); PG8_STAGE(PG8_SA(0, 1), a2 + hstA, voffA);
            PG8_WAIT_V(8); PG8_WAIT_L(0); PG8_BAR; PG8_MMA(0, 0, At, B0); PG8_MMA(0, 1, At, B1); PG8_BAR; PG8_SCHED;
            PG8_LDA(At, 1, 1); PG8_STAGE(PG8_SB(1, 0), b3, voffB); PG8_STAGE(PG8_SB(1, 1), b3 + hstB, voffB); PG8_STAGE(PG8_SA(1, 0), a3, voffA);
            PG8_WAIT_V(8); PG8_WAIT_L(0); PG8_BAR; PG8_MMA(1, 0, At, B0); PG8_MMA(1, 1, At, B1); PG8_BAR; PG8_SCHED;
            } else {
            PG8_LDB(B0, 0, 0); PG8_SCHED; PG8_LDA(At, 0, 0); PG8_STAGE(PG8_SA(1, 1), a1 + hstA, voffA);
            PG8_WAIT_L(8); PG8_BAR; PG8_WAIT_L(0); PG8_MMA(0, 0, At, B0); PG8_BAR; PG8_SCHED;
            PG8_LDB(B1, 0, 1); PG8_STAGE(PG8_SB(0, 0), b2, voffB);
            PG8_BAR; PG8_WAIT_L(0); PG8_MMA(0, 1, At, B1); PG8_BAR;
            PG8_LDA(At, 0, 1); PG8_STAGE(PG8_SA(0, 0), a2, voffA);
            PG8_BAR; PG8_WAIT_L(0); PG8_MMA(1, 0, At, B0); PG8_BAR; PG8_SCHED;
            PG8_STAGE(PG8_SB(0, 1), b2 + hstB, voffB);
            PG8_WAIT_V(6); PG8_BAR; PG8_MMA(1, 1, At, B1); PG8_BAR;
            PG8_LDB(B0, 1, 0); PG8_SCHED; PG8_LDA(At, 1, 0); PG8_STAGE(PG8_SA(0, 1), a2 + hstA, voffA);
            PG8_WAIT_L(8); PG8_BAR; PG8_WAIT_L(0); PG8_MMA(0, 0, At, B0); PG8_BAR; PG8_SCHED;
            PG8_LDB(B1, 1, 1); PG8_STAGE(PG8_SB(1, 0), b3, voffB);
            PG8_BAR; PG8_WAIT_L(0); PG8_MMA(0, 1, At, B1); PG8_BAR;
            PG8_LDA(At, 1, 1); PG8_STAGE(PG8_SA(1, 0), a3, voffA);
            PG8_BAR; PG8_WAIT_L(0); PG8_MMA(1, 0, At, B0); PG8_BAR; PG8_SCHED;
            PG8_STAGE(PG8_SB(1, 1), b3 + hstB, voffB);
            PG8_WAIT_V(6); PG8_BAR; PG8_MMA(1, 1, At, B1); PG8_BAR;
            }
        }
        if constexpr (ALIGN_EPI) { if (wr == 0) PG8_BAR; }
        if constexpr (!Epi::AFTER_DRAIN) { E(acc, cur, wr, wc, fr, fq); S.done(cur); }
        if (!has_next) break;
#pragma unroll
        for (int a = 0; a < 2; ++a)
#pragma unroll
            for (int b = 0; b < 2; ++b)
#pragma unroll
                for (int m = 0; m < 4; ++m)
#pragma unroll
                    for (int n = 0; n < 2; ++n) acc[a][b][m][n] = (f32x4){0.f, 0.f, 0.f, 0.f};
        cur = nxt; cA = nA; cB = nB; ++ui;
        if constexpr (ALIGN_EPI) { if (wr == 1) PG8_BAR; }
    }
    PG8_WAIT_V(0);
    if constexpr (!ALIGN_EPI) { if (wr == 0) PG8_BAR; }
    PG8_BAR;
    if constexpr (Epi::AFTER_DRAIN) { E.fused(acc, cur, wr, wc, fr, fq, lds, wid, lane); S.done(cur); }
#undef PG8_SA
#undef PG8_SB
#undef PG8_STAGE
#undef PG8_LDA
#undef PG8_LDB
#undef PG8_MMA
#undef PG8_WAIT_V
#undef PG8_WAIT_L
#undef PG8_BAR
#undef PG8_SCHED
}
}
constexpr int SEQ = 8192, DM = 4096, DFF = 11008, NIN = 11312, LDP = 11520;
constexpr int HD = 128, DIFF_H = 8, NSA_H = 16, NSA_KV = 4;
constexpr int OFF_DQ = 0, OFF_DK = 2048, OFF_DV = 4096, OFF_NQ = 6144, OFF_KC = 8192, OFF_VC = 8704, OFF_KS = 9216, OFF_VS = 9728, OFF_KW = 10240, OFF_VW = 10752, OFF_G = 11264;
#define PVEC(p, col) ((p) + (size_t)((col) >> 7) * ((size_t)SEQ * 128))
constexpr float EPS = 1e-6f, LOG2E = 1.4426950408889634f, QSCALE = 0.08838834764831845f * 1.4426950408889634f;
constexpr float LAM0 = 0.2f;
constexpr int NWAVES = 8;
constexpr size_t MiB = 1u << 20;
constexpr size_t WS_CTL = 0, CTL_ZERO_BYTES = 1 * MiB;
constexpr size_t WS_SCR = 922 * MiB;
constexpr size_t WS_KC = 34 * MiB, WS_VC = WS_KC + 512 * 1024;
constexpr size_t WS_W1K = 35 * MiB, WS_W1V = 37 * MiB, WS_W2K = 39 * MiB, WS_W2V = WS_W2K + 65536;
constexpr size_t WS_WOUT = 40 * MiB, WS_WIN = 72 * MiB, WS_WGU1 = 162 * MiB, WS_WD1 = 334 * MiB, WS_WGU2 = 420 * MiB, WS_WD2 = 592 * MiB;
constexpr size_t WS_UB = 678 * MiB;
constexpr size_t WS_HID = 742 * MiB;
constexpr size_t WS_DPART = 986 * MiB;
constexpr size_t WS_END = 1114 * MiB;
constexpr int CW_DBG = 64;
constexpr int CW_QUEUE = 1024;
constexpr int CW_NORM = 16384;
constexpr int CW_DCNT = 65536;
constexpr int CW_RSS1 = 131072, CW_RSS2 = 139264;
constexpr int CW_BAR = 4096;
constexpr int RING_BYTES = 131072;
constexpr int AT_BUFSZ = 49152, AT_KSZ = 16384, AT_WS = 98304, AT_LIST = 100352, AT_GATE = 101440, AT_SELM = 104512, AT_UNI = 105536, AT_IMP = 105600, AT_SS = 138624, AT_ORD = 139648, AT_END = 140736;
constexpr int LDSCTL_OFF = 151552, MISC_OFF = LDSCTL_OFF + 320, LDS_BYTES = 155648;
static_assert(AT_END <= LDSCTL_OFF && MISC_OFF + 128 <= LDS_BYTES, "LDS map");

#define GAS __attribute__((address_space(1)))
#define LAS __attribute__((address_space(3)))
typedef unsigned short bf16;
typedef unsigned v4u __attribute__((ext_vector_type(4)));
typedef unsigned v2u __attribute__((ext_vector_type(2)));
typedef float f32x4 __attribute__((ext_vector_type(4)));
typedef float f32x16 __attribute__((ext_vector_type(16)));
typedef short bf16x8 __attribute__((ext_vector_type(8)));
typedef short s16x4 __attribute__((ext_vector_type(4)));
typedef GAS unsigned gu32;
#define RLX_AGENT __ATOMIC_RELAXED, __HIP_MEMORY_SCOPE_AGENT
#define LDS_WAIT() asm volatile("s_waitcnt lgkmcnt(0)" ::: "memory")
#define VM_WAIT() asm volatile("s_waitcnt vmcnt(0)" ::: "memory")
#define SBAR() __builtin_amdgcn_sched_barrier(0)
typedef float f32x2_t __attribute__((ext_vector_type(2))); typedef __bf16 bf16x2_t __attribute__((ext_vector_type(2)));
__device__ __forceinline__ unsigned cvtpk(float lo, float hi) { f32x2_t v = {lo, hi}; bf16x2_t b = __builtin_convertvector(v, bf16x2_t); return __builtin_bit_cast(unsigned, b); }
__device__ __forceinline__ float bf2f(unsigned short b) { return __uint_as_float(((unsigned)b) << 16); }
template <int K> __device__ __forceinline__ float swz_xor(float v) { return __int_as_float(__builtin_amdgcn_ds_swizzle(__float_as_int(v), (K << 10) | 0x1f)); }
__device__ __forceinline__ float dpp_xor1(float v) { return __int_as_float(__builtin_amdgcn_mov_dpp(__float_as_int(v), 0xB1, 0xF, 0xF, true)); }
__device__ __forceinline__ float wave_sum(float v) {
#pragma unroll
    for (int o = 1; o < 64; o <<= 1) v += __shfl_xor(v, o);
    return v;
}
#define XB_TMO      128
#define XB_XCNT(j)  (256  + 64 * (j))
#define XB_XSUB(j)  (1280 + 64 * (j))
#define XB_XGEN(j)  (2304 + 64 * (j))
#define XB_TOP      3328
#define XB_TOPGEN   3392
#define XCD_BAR_WORDS 3456
#define XB_SPIN_CAP (1u << 18)

__device__ __forceinline__ unsigned xb_ld(unsigned* p)              { return __hip_atomic_load(p, __ATOMIC_RELAXED, __HIP_MEMORY_SCOPE_AGENT); }
__device__ __forceinline__ unsigned xb_add(unsigned* p, unsigned v) { return __hip_atomic_fetch_add(p, v, __ATOMIC_RELAXED, __HIP_MEMORY_SCOPE_AGENT); }
__device__ __forceinline__ unsigned xb_xcc_id() { return (unsigned)__builtin_amdgcn_s_getreg((3 << 11) | 20) & 0xFu; }
#define XB_SPIN(cond, bar) do { unsigned _sp = 0; while (cond) { __builtin_amdgcn_s_sleep(1); \
    if ((++_sp & 255u) == 0u) { if (xb_ld(&(bar)[XB_TMO])) break; if (_sp > XB_SPIN_CAP) { atomicAdd(&(bar)[XB_TMO], 1u); break; } } } } while (0)

struct XcdBarrier {
    unsigned* bar; unsigned x;
    volatile LAS unsigned* st;
};

__device__ __forceinline__ XcdBarrier xcd_barrier_post(unsigned* bar, volatile LAS unsigned* st) {
    XcdBarrier b; b.bar = bar; b.x = xb_xcc_id(); b.st = st;
    if (threadIdx.x == 0) (void)xb_add(&bar[XB_XCNT(b.x)], 1u);
    return b;
}
__device__ __forceinline__ void xcd_barrier_complete(unsigned* bar, unsigned x, unsigned& nloc, unsigned& nx) {
    const unsigned G = gridDim.x * gridDim.y * gridDim.z;
    unsigned sum, cnt, mine, sp = 0u;
    for (;;) {
        sum = 0u; cnt = 0u; mine = 0u;
#pragma unroll
        for (unsigned j = 0; j < 16; ++j) { const unsigned c = xb_ld(&bar[XB_XCNT(j)]); sum += c; cnt += (c > 0u) ? 1u : 0u; mine = (j == x) ? c : mine; }
        if (sum == G) break;
        __builtin_amdgcn_s_sleep(1);
        if ((++sp & 255u) == 0u) { if (xb_ld(&bar[XB_TMO])) break; if (sp > XB_SPIN_CAP) { atomicAdd(&bar[XB_TMO], 1u); break; } }
    }
    nloc = mine > 0u ? mine : 1u; nx = cnt > 0u ? cnt : 1u;
}

__device__ __forceinline__ void xcd_barrier(const XcdBarrier& b) {
    asm volatile("s_waitcnt vmcnt(0)" ::: "memory");
    __syncthreads();
    if (threadIdx.x == 0) {
        unsigned* bar = b.bar;
        __builtin_amdgcn_s_waitcnt(0);
        unsigned nloc = b.st[0], nx = b.st[1];
        if (nloc == 0u) { xcd_barrier_complete(bar, b.x, nloc, nx); b.st[0] = nloc; b.st[1] = nx; }
        const unsigned old = xb_add(&bar[XB_XSUB(b.x)], 1u);
        const unsigned gen = old / nloc;
        if (old + 1u == (gen + 1u) * nloc) {
            __builtin_amdgcn_fence(__ATOMIC_RELEASE, "agent");
            asm volatile("s_waitcnt vmcnt(0)" ::: "memory");
            const unsigned og = xb_add(&bar[XB_TOP], 1u);
            const unsigned tg = og / nx;
            if (og + 1u == (tg + 1u) * nx) xb_add(&bar[XB_TOPGEN], 1u);
            else XB_SPIN(xb_ld(&bar[XB_TOPGEN]) == tg, bar);
            __builtin_amdgcn_fence(__ATOMIC_ACQUIRE, "agent");
            xb_add(&bar[XB_XGEN(b.x)], 1u);
            asm volatile("s_waitcnt vmcnt(0)" ::: "memory");
        } else {
            XB_SPIN(xb_ld(&bar[XB_XGEN(b.x)]) == gen, bar);
            __builtin_amdgcn_fence(__ATOMIC_ACQUIRE, "agent");
            asm volatile("s_waitcnt vmcnt(0)" ::: "memory");
        }
    }
    __syncthreads();
}
__device__ __forceinline__ int inv_perm32(int v) { return 16 * ((v >> 2) & 1) + 4 * (v >> 3) + (v & 3); }
__device__ __forceinline__ void tr_load(const float* __restrict__ W, int N, int item, int lane, f32x4 (&v)[16]) {
    const int nnb = (N + 63) >> 6, kb = item / nnb, nb = item - kb * nnb, k0 = kb * 64, n0 = nb * 64;
    const int c4 = (lane & 15) * 4, col = (n0 + c4 + 3 < N) ? n0 + c4 : 0;
    const float* p = W + (size_t)(k0 + (lane >> 4)) * N + col;
#pragma unroll
    for (int q = 0; q < 16; ++q) v[q] = *(const GAS f32x4*)(p + (size_t)(4 * q) * N);
}
__device__ __forceinline__ void tr_store(const f32x4 (&v)[16], int K, int N, bf16* WT, int mode, LAS float* scr, int item, int lane, int img) {
    const int nnb = (N + 63) >> 6, kb = item / nnb, nb = item - kb * nnb, k0 = kb * 64, n0 = nb * 64;
    { LAS float* w = scr + (lane >> 4) * 65 + (lane & 15) * 4;
#pragma unroll
      for (int q = 0; q < 16; ++q) { w[(4 * q) * 65 + 0] = v[q].x; w[(4 * q) * 65 + 1] = v[q].y; w[(4 * q) * 65 + 2] = v[q].z; w[(4 * q) * 65 + 3] = v[q].w; } }
    LDS_WAIT(); asm volatile("" ::: "memory");
    const int c = lane & 7;
    const int drow0 = (mode == 0) ? n0 : (256 * (n0 >> 7) + (n0 & 127) + (mode == 2 ? 128 : 0));
#pragma unroll
    for (int j = 0; j < 8; ++j) { const int nn = (lane >> 3) + 8 * j; const LAS float* s = scr + (8 * c) * 65 + nn;
        v4u o; o.x = cvtpk(s[0], s[65]); o.y = cvtpk(s[130], s[195]); o.z = cvtpk(s[260], s[325]); o.w = cvtpk(s[390], s[455]);
        if (n0 + nn < N) { const int drow = drow0 + nn;
            if (img == 0) *(GAS v4u*)(WT + (size_t)drow * K + k0 + 8 * c) = o;
            else { const int r128 = drow & 127, rho = (img == 2) ? ((r128 & ~31) + inv_perm32(r128 & 31)) : r128;
                   *(GAS v4u*)((char*)WT + ((size_t)(drow >> 7) * (K >> 6) + kb) * 16384 + pg8::lds_byte(rho, 8 * c)) = o; } } }
    LDS_WAIT(); asm volatile("" ::: "memory");
}
__device__ __forceinline__ void tr_range(const float* __restrict__ W, int K, int N, bf16* WT, int mode, LAS float* scr, int lo, int hi, int w, int nw, int lane, int img) {
    int it = lo + w;
    if (it >= hi) return;
    f32x4 va[16], vb[16];
    tr_load(W, N, it, lane, va);
    for (;;) {
        const int n1 = it + nw;
        if (n1 < hi) tr_load(W, N, n1, lane, vb);
        tr_store(va, K, N, WT, mode, scr, it, lane, img);
        if (n1 >= hi) break;
        const int n2 = n1 + nw;
        if (n2 < hi) tr_load(W, N, n2, lane, va);
        tr_store(vb, K, N, WT, mode, scr, n1, lane, img);
        if (n2 >= hi) break;
        it = n2;
    }
}
__device__ __forceinline__ void tr_matrix(const float* __restrict__ W, int K, int N, bf16* WT, int mode, LAS float* scr, int gw, int ngw, int lane, int img = 0) {
    tr_range(W, K, N, WT, mode, scr, 0, (K >> 6) * ((N + 63) >> 6), gw, ngw, lane, img);
}
__device__ __forceinline__ void tile_w1(const float* __restrict__ W1, bf16* W1f, int gw, int ngw, int lane) {
    const int r32 = lane & 31, hi = lane >> 5;
    for (int f = gw; f < 256 * 8; f += ngw) { const int step = f >> 3, cb = f & 7;
        const float* s = W1 + (size_t)(16 * step + 8 * hi) * 256 + 32 * cb + r32;
        v4u o; o.x = cvtpk(s[0], s[256]); o.y = cvtpk(s[512], s[768]); o.z = cvtpk(s[1024], s[1280]); o.w = cvtpk(s[1536], s[1792]);
        *(GAS v4u*)(W1f + ((size_t)f * 64 + lane) * 8) = o; }
}
__device__ __forceinline__ void rms_rows_bf16(const float* X, const float* __restrict__ g, bf16* O, int gw, int ngw, int lane) {
    for (int m = gw; m < SEQ; m += ngw) {
        const GAS f32x4* xr = (const GAS f32x4*)(X + (size_t)m * DM) + lane;
        f32x4 v[16]; float s = 0.f;
#pragma unroll
        for (int j = 0; j < 16; ++j) { v[j] = xr[64 * j]; s += (v[j].x * v[j].x + v[j].y * v[j].y) + (v[j].z * v[j].z + v[j].w * v[j].w); }
        const float rstd = 1.0f / sqrtf(wave_sum(s) * (1.0f / DM) + EPS);
        GAS v2u* o8 = (GAS v2u*)(O + (size_t)m * DM) + lane;
#pragma unroll
        for (int j = 0; j < 16; ++j) { const f32x4 gv = ((const f32x4*)g)[lane + 64 * j]; v2u w; w.x = cvtpk(v[j].x * rstd * gv.x, v[j].y * rstd * gv.y); w.y = cvtpk(v[j].z * rstd * gv.z, v[j].w * rstd * gv.w); o8[64 * j] = w; }
    }
}
__device__ __forceinline__ void rms_rows_f32(float* X, const float* __restrict__ g, int gw, int ngw, int lane) {
    for (int m = gw; m < SEQ; m += ngw) {
        GAS f32x4* xr = (GAS f32x4*)(X + (size_t)m * DM) + lane;
        f32x4 v[16]; float s = 0.f;
#pragma unroll
        for (int j = 0; j < 16; ++j) { v[j] = xr[64 * j]; s += (v[j].x * v[j].x + v[j].y * v[j].y) + (v[j].z * v[j].z + v[j].w * v[j].w); }
        const float rstd = 1.0f / sqrtf(wave_sum(s) * (1.0f / DM) + EPS);
#pragma unroll
        for (int j = 0; j < 16; ++j) { const f32x4 gv = ((const f32x4*)g)[lane + 64 * j]; xr[64 * j] = v[j] * rstd * gv; }
    }
}
__device__ __forceinline__ int crow(int r, int hi) { return (r & 3) + 8 * (r >> 2) + 4 * hi; }
__device__ __forceinline__ void compress_task(const bf16* proj, int off_kv, const float* __restrict__ pos, const bf16* __restrict__ W1t, const bf16* __restrict__ W2t, bf16* outc, int rb,
                                              char* shm, int wave, int lane) {
    const int r32 = lane & 31, hi = lane >> 5, tid = wave * 64 + lane;
    const int h = rb >> 4, c = ((rb & 15) << 5) + r32, ce = c < 511 ? c : 510;
    float* hsum = (float*)(shm + 32768);
    for (int i = tid; i < 32 * 256; i += 512) hsum[i] = 0.f;
    f32x16 acc[8];
#pragma unroll
    for (int cb = 0; cb < 8; ++cb) acc[cb] = f32x16{};
    const bf16* arow = PVEC(proj, off_kv + h * HD) + (size_t)(16 * ce + 4 * wave) * 128 + hi * 8;
    const float* prow = pos + (4 * wave) * HD + hi * 8;
    const bf16* bfrag = W1t + ((size_t)(32 * wave) * 8 * 64 + lane) * 8;
#pragma unroll 1
    for (int l = 0; l < 4; ++l) {
#pragma unroll 2
        for (int j = 0; j < 8; ++j) {
            const v4u av = *(const v4u*)(arow + (size_t)l * 128 + 16 * j);
            const f32x4 p0 = *(const f32x4*)(prow + l * HD + 16 * j), p1 = *(const f32x4*)(prow + l * HD + 16 * j + 4);
            bf16x8 bv[8];
#pragma unroll
            for (int cb = 0; cb < 8; ++cb) bv[cb] = *(const bf16x8*)(bfrag + (size_t)(((l * 8 + j) * 8 + cb) * 64) * 8);
            v4u aw;
            aw.x = cvtpk(__uint_as_float(av.x << 16) + p0.x, __uint_as_float(av.x & 0xffff0000u) + p0.y);
            aw.y = cvtpk(__uint_as_float(av.y << 16) + p0.z, __uint_as_float(av.y & 0xffff0000u) + p0.w);
            aw.z = cvtpk(__uint_as_float(av.z << 16) + p1.x, __uint_as_float(av.z & 0xffff0000u) + p1.y);
            aw.w = cvtpk(__uint_as_float(av.w << 16) + p1.z, __uint_as_float(av.w & 0xffff0000u) + p1.w);
            const bf16x8 af = __builtin_bit_cast(bf16x8, aw);
#pragma unroll
            for (int cb = 0; cb < 8; ++cb) acc[cb] = __builtin_amdgcn_mfma_f32_32x32x16_bf16(af, bv[cb], acc[cb], 0, 0, 0);
        }
    }
    __syncthreads();
#pragma unroll
    for (int cb = 0; cb < 8; ++cb)
#pragma unroll
        for (int r = 0; r < 16; ++r) atomicAdd((int*)hsum + crow(r, hi) * 256 + 32 * cb + r32, (int)rintf(acc[cb][r] * 65536.f));
    __syncthreads();
    bf16* hid = (bf16*)shm;
    for (int i = tid; i < 32 * 256; i += 512) { const float x = (float)((const int*)hsum)[i] * (1.0f / 65536.f); const float y = 1.5957691216057308f * (x + 0.044715f * x * x * x);
        const float gl = x * __builtin_amdgcn_rcpf(1.0f + __builtin_amdgcn_exp2f(-LOG2E * y));
        hid[(i >> 8) * 264 + (i & 255)] = (bf16)(cvtpk(gl, 0.f) & 0xffffu); }
    __syncthreads();
    if (wave < 4) {
        f32x16 a2 = {};
        const bf16* b2 = W2t + (size_t)(32 * wave + r32) * 256 + hi * 8;
#pragma unroll
        for (int kk = 0; kk < 16; ++kk) {
            const bf16x8 af = *(const bf16x8*)(hid + r32 * 264 + 16 * kk + hi * 8);
            const bf16x8 bv = *(const bf16x8*)(b2 + 16 * kk);
            a2 = __builtin_amdgcn_mfma_f32_32x32x16_bf16(af, bv, a2, 0, 0, 0);
        }
#pragma unroll
        for (int r = 0; r < 16; ++r) { const int cr = ((rb & 15) << 5) + crow(r, hi);
            outc[((size_t)h * 512 + cr) * HD + 32 * wave + r32] = (cr < 511) ? (bf16)(cvtpk(a2[r], 0.f) & 0xffffu) : (bf16)0; }
    }
    __syncthreads();
}
#define KSWZ(row, colB) ((row) * 256 + ((colB) ^ (((row) & 7) << 4)))
__device__ __forceinline__ int v_st(int k, int c) { const int kk = (k & ~0xC) | ((k & 4) << 1) | ((k & 8) >> 1); return ((kk >> 3) * 4 + (c >> 5)) * 512 + ((kk & 7) * 32 + (c & 31)) * 2; }
__device__ __forceinline__ int v_rd_base(int lane) { return ((lane & 3) << 3) | (((lane >> 2) & 3) << 6) | (((lane >> 4) & 1) << 5) | (((lane >> 5) & 1) << 8); }
constexpr int v_rd_off(int d0, int ks, int half) { return d0 * 512 + ks * 4096 + half * 2048; }
struct AttnP { const bf16* Kg; const bf16* Vg; int ldk; int ntiles; int tq; unsigned W; float sl2; float tref; };

__device__ __forceinline__ void qkt(f32x16& p0, f32x16& p1, const char* Kt, int r32, int hi, const bf16x8 (&qr)[8]) {
    const char* kb[4];
#pragma unroll
    for (int dd = 0; dd < 4; ++dd) kb[dd] = Kt + KSWZ(r32, (dd * 16 + hi * 8) * 2);
#pragma unroll
    for (int d0 = 0; d0 < 8; ++d0) { const char* a = kb[d0 & 3] + (d0 >> 2) * 128;
        const bf16x8 b0 = *reinterpret_cast<const bf16x8*>(a);
        const bf16x8 b1 = *reinterpret_cast<const bf16x8*>(a + 32 * 256);
        p0 = __builtin_amdgcn_mfma_f32_32x32x16_bf16(b0, qr[d0], p0, 0, 0, 0);
        p1 = __builtin_amdgcn_mfma_f32_32x32x16_bf16(b1, qr[d0], p1, 0, 0, 0); }
}
#define KRD_(dst, ad, off) asm volatile("ds_read_b128 %0, %1 offset:%2" : "=&v"(dst) : "v"(ad), "i"(off) : "memory")
#define KPAIR_(j) do { KRD_(b0[j], ka[(j) & 3], ((j) >> 2) * 128); KRD_(b1[j], ka[(j) & 3], ((j) >> 2) * 128 + 8192); } while (0)
#define KWAIT_(n) asm volatile("s_waitcnt lgkmcnt(%0)" :: "i"(n) : "memory")
template <int WIN>
__device__ __forceinline__ void qkt_pre(f32x16& p0, f32x16& p1, const char* Kt, int r32, int hi, const bf16x8 (&qr)[8]) {
    int ka[4];
#pragma unroll
    for (int dd = 0; dd < 4; ++dd) ka[dd] = (int)(unsigned)(uintptr_t)Kt + KSWZ(r32, (dd * 16 + hi * 8) * 2);
    bf16x8 b0[8], b1[8];
    KWAIT_(0); SBAR();
#define KSTEP_(j) do { if ((j) + WIN < 8) KPAIR_(((j) + WIN) & 7); \
        { constexpr int out_ = ((j) + WIN < 8 ? WIN : 7 - (j)) * 2; KWAIT_(out_); } SBAR(); \
        p0 = __builtin_amdgcn_mfma_f32_32x32x16_bf16(b0[j], qr[j], p0, 0, 0, 0); p1 = __builtin_amdgcn_mfma_f32_32x32x16_bf16(b1[j], qr[j], p1, 0, 0, 0); SBAR(); } while (0)
    KPAIR_(0); if (WIN > 1) KPAIR_(1); if (WIN > 2) KPAIR_(2); if (WIN > 3) KPAIR_(3); if (WIN > 4) KPAIR_(4); if (WIN > 5) KPAIR_(5); if (WIN > 6) KPAIR_(6); if (WIN > 7) KPAIR_(7);
    KSTEP_(0); KSTEP_(1); KSTEP_(2); KSTEP_(3); KSTEP_(4); KSTEP_(5); KSTEP_(6); KSTEP_(7);
#undef KSTEP_
}
__device__ __forceinline__ void pv_tile(f32x16 (&o)[4], int vb0, bf16x8 pa0, bf16x8 pa1, bf16x8 pa2, bf16x8 pa3) {
#define TRRD(dst, off) asm volatile("ds_read_b64_tr_b16 %0, %1 offset:%2" : "=&v"(dst) : "v"(vb0), "i"(off) : "memory")
#define PV_D0(d0) do { s16x4 l0, l1, l2, l3, h0, h1, h2, h3; constexpr int b_ = v_rd_off(d0, 0, 0); \
        TRRD(l0, b_); TRRD(h0, b_ + 2048); TRRD(l1, b_ + 4096); TRRD(h1, b_ + 6144); TRRD(l2, b_ + 8192); TRRD(h2, b_ + 10240); TRRD(l3, b_ + 12288); TRRD(h3, b_ + 14336); \
        asm volatile("s_waitcnt lgkmcnt(0)" ::: "memory"); SBAR(); \
        o[d0] = __builtin_amdgcn_mfma_f32_32x32x16_bf16(pa0, (bf16x8){l0[0], l0[1], l0[2], l0[3], h0[0], h0[1], h0[2], h0[3]}, o[d0], 0, 0, 0); \
        o[d0] = __builtin_amdgcn_mfma_f32_32x32x16_bf16(pa1, (bf16x8){l1[0], l1[1], l1[2], l1[3], h1[0], h1[1], h1[2], h1[3]}, o[d0], 0, 0, 0); \
        o[d0] = __builtin_amdgcn_mfma_f32_32x32x16_bf16(pa2, (bf16x8){l2[0], l2[1], l2[2], l2[3], h2[0], h2[1], h2[2], h2[3]}, o[d0], 0, 0, 0); \
        o[d0] = __builtin_amdgcn_mfma_f32_32x32x16_bf16(pa3, (bf16x8){l3[0], l3[1], l3[2], l3[3], h3[0], h3[1], h3[2], h3[3]}, o[d0], 0, 0, 0); } while (0)
    PV_D0(0); PV_D0(1); PV_D0(2); PV_D0(3);
#undef PV_D0
#undef TRRD
}
#define TRRD2(dst, off) asm volatile("ds_read_b64_tr_b16 %0, %1 offset:%2" : "=&v"(dst) : "v"(vb0), "i"(off) : "memory")
#define PVP_RD(S, g) do { constexpr int b_ = ((g) >> 2) * 16384 + ((g) & 3) * 512; TRRD2(S[0], b_); TRRD2(S[1], b_ + 2048); TRRD2(S[2], b_ + 4096); TRRD2(S[3], b_ + 6144); \
        TRRD2(S[4], b_ + 8192); TRRD2(S[5], b_ + 10240); TRRD2(S[6], b_ + 12288); TRRD2(S[7], b_ + 14336); } while (0)
#define PVP_MM(S, g) do { \
        o[g] = __builtin_amdgcn_mfma_f32_32x32x16_bf16(pa0, (bf16x8){S[0][0], S[0][1], S[0][2], S[0][3], S[1][0], S[1][1], S[1][2], S[1][3]}, o[g], 0, 0, 0); \
        o[g] = __builtin_amdgcn_mfma_f32_32x32x16_bf16(pa1, (bf16x8){S[2][0], S[2][1], S[2][2], S[2][3], S[3][0], S[3][1], S[3][2], S[3][3]}, o[g], 0, 0, 0); \
        o[g] = __builtin_amdgcn_mfma_f32_32x32x16_bf16(pa2, (bf16x8){S[4][0], S[4][1], S[4][2], S[4][3], S[5][0], S[5][1], S[5][2], S[5][3]}, o[g], 0, 0, 0); \
        o[g] = __builtin_amdgcn_mfma_f32_32x32x16_bf16(pa3, (bf16x8){S[6][0], S[6][1], S[6][2], S[6][3], S[7][0], S[7][1], S[7][2], S[7][3]}, o[g], 0, 0, 0); } while (0)
#define PVP_STEP(CUR, NXT, g, NG_) do { if ((g) + 1 < (NG_)) { PVP_RD(NXT, (g) + 1); asm volatile("s_waitcnt lgkmcnt(8)" ::: "memory"); } else { asm volatile("s_waitcnt lgkmcnt(0)" ::: "memory"); } SBAR(); PVP_MM(CUR, g); SBAR(); } while (0)
template <int NG>
__device__ __forceinline__ void pv_pipe(f32x16 (&o)[NG], int vb0, bf16x8 pa0, bf16x8 pa1, bf16x8 pa2, bf16x8 pa3) {
    s16x4 A[8], B[8];
    asm volatile("s_waitcnt lgkmcnt(0)" ::: "memory"); SBAR();
    PVP_RD(A, 0);
    PVP_STEP(A, B, 0, NG); PVP_STEP(B, A, 1, NG); PVP_STEP(A, B, 2, NG); PVP_STEP(B, A, 3, NG);
    if constexpr (NG == 8) { PVP_STEP(A, B, 4, NG); PVP_STEP(B, A, 5, NG); PVP_STEP(A, B, 6, NG); PVP_STEP(B, A, 7, NG); }
}
template <bool IMP, bool SEL, bool NOPV = false>
__device__ __forceinline__ void attn_run(char* shm, const AttnP a, const bf16x8 (&qr)[8], f32x16 (&o)[4], float& m_reg, float& l_reg, int vhalf,
                                         float inv_l, int impq) {
    int tid_ = threadIdx.x; asm volatile("" : "+v"(tid_));
    const int tid = tid_, wid = __builtin_amdgcn_readfirstlane(tid >> 6), lane = tid & 63, r32 = lane & 31, hi = lane >> 5;
    float* wsf = (float*)(shm + AT_WS) + wid * 64;
    int wbo_ = AT_WS + wid * 256 + 16 * hi; asm volatile("" : "+v"(wbo_)); const LAS float* wb = (const LAS float*)((LAS char*)shm + wbo_);
    const int* list = (const int*)(shm + AT_LIST);
    const int vb00 = (int)(unsigned)(uintptr_t)shm + AT_KSZ + v_rd_base(lane); (void)vhalf;
    unsigned koff[2], voff[2];
#pragma unroll
    for (int i2 = 0; i2 < 2; ++i2) { const int pk = wid * 2 + i2;
        const int row = 4 * pk + (lane >> 4), c = (lane & 15) ^ (row & 7); koff[i2] = (unsigned)(row * a.ldk + c * 8) * 2u;
        const int st = 2 * pk + (lane >> 5), pos = lane & 31, kk = (st >> 2) * 8 + (pos >> 2), k = (kk & ~0xC) | ((kk & 4) << 1) | ((kk & 8) >> 1), cv = (st & 3) * 32 + (pos & 3) * 8;
        voff[i2] = (unsigned)(k * a.ldk + cv) * 2u; }
    LAS unsigned char* lbase = (LAS unsigned char*)shm + wid * 2048;
#define DMA16(gp_, lp_) __builtin_amdgcn_global_load_lds((const unsigned*)(gp_), (LAS unsigned*)(lp_), 16, 0, 0)
#define STAGE(kb_, bo_) do { const char* kt_ = (const char*)(a.Kg + (size_t)(kb_) * a.ldk); const char* vt_ = (const char*)(a.Vg + (size_t)(kb_) * a.ldk); \
        DMA16(kt_ + koff[0], lbase + (bo_)); DMA16(kt_ + koff[1], lbase + (bo_) + 1024); \
        DMA16(vt_ + voff[0], lbase + (bo_) + AT_KSZ); DMA16(vt_ + voff[1], lbase + (bo_) + AT_KSZ + 1024); } while (0)
    int kb = __builtin_amdgcn_readfirstlane(list[0]);
    STAGE(kb, 0);
    int kbn = kb;
    if (a.ntiles > 1) { kbn = __builtin_amdgcn_readfirstlane(list[1]); STAGE(kbn, 32768); }
    VM_WAIT(); __syncthreads();
    int bo = 0;
    for (int i = 0; i < a.ntiles; ++i) {
        const bool more2 = i + 2 < a.ntiles;
        int kbn2 = kbn;
        if (more2) { kbn2 = __builtin_amdgcn_readfirstlane(list[i + 2]); const int b2 = bo >= 32768 ? bo - 32768 : bo + 65536; STAGE(kbn2, b2); }
        const int d0 = a.tq - kb;
        bool selok = true;
        if (SEL) { const int blk = kb >> 6; const unsigned w = ((const unsigned*)(shm + AT_SELM))[impq * 4 + (blk >> 5)]; selok = ((w >> (blk & 31)) & 1u) != 0u; }
        const bool anyv = selok && d0 >= 0 && (d0 - 63 < (int)a.W), full = selok && d0 >= 63 && (unsigned)d0 < a.W;
        if (__any(anyv)) {
        const bool unset = m_reg < -1e29f;
        const float ref = unset ? 0.f : m_reg;
        f32x16 p0, p1;
        { const float B0 = a.sl2 * ((float)(kb + 4 * hi) - a.tref) - ref;
#pragma unroll
          for (int r = 0; r < 16; ++r) { p0[r] = __builtin_fmaf(a.sl2, (float)((r & 3) + 8 * (r >> 2)), B0); p1[r] = __builtin_fmaf(a.sl2, (float)((r & 3) + 8 * (r >> 2) + 32), B0); } }
        qkt(p0, p1, shm + bo, r32, hi, qr);
        if (!__all(full)) {
            const int dq = selok ? d0 - 4 * hi : -1; const float NEG = -__builtin_inff();
#pragma unroll
            for (int r = 0; r < 16; ++r) { const int c = (r & 3) + 8 * (r >> 2);
                if ((unsigned)(dq - c) >= a.W) p0[r] = NEG;
                if ((unsigned)(dq - c - 32) >= a.W) p1[r] = NEG; } }
        float pmax = p0[0];
#pragma unroll
        for (int r = 1; r < 16; ++r) pmax = fmaxf(pmax, p0[r]);
#pragma unroll
        for (int r = 0; r < 16; ++r) pmax = fmaxf(pmax, p1[r]);
        { auto rr = __builtin_amdgcn_permlane32_swap(__float_as_uint(pmax), __float_as_uint(pmax), false, false); pmax = fmaxf(__uint_as_float(rr[0]), __uint_as_float(rr[1])); }
        const bool need = unset ? (pmax > -1e30f) : (pmax > 8.0f);
        if (__any(need)) {
            const float delta = need ? pmax : 0.f, alpha = (need && !unset) ? __builtin_amdgcn_exp2f(-pmax) : 1.0f;
            m_reg = need ? ref + pmax : m_reg;
#pragma unroll
            for (int r = 0; r < 16; ++r) { p0[r] -= delta; p1[r] -= delta; }
            l_reg *= alpha;
            if (__any(alpha < 1.f)) { if (hi == 0) wsf[r32] = alpha; LDS_WAIT();
#pragma unroll
                for (int r = 0; r < 16; ++r) { const float f = wb[(r & 3) + 8 * (r >> 2)];
#pragma unroll
                    for (int d = 0; d < 4; ++d) o[d][r] *= f; }
                LDS_WAIT(); }
        }
#pragma unroll
        for (int r = 0; r < 16; ++r) { p0[r] = __builtin_amdgcn_exp2f(p0[r]); p1[r] = __builtin_amdgcn_exp2f(p1[r]); }
        float ps = 0.f;
#pragma unroll
        for (int r = 0; r < 16; ++r) ps += p0[r] + p1[r];
        { auto rr = __builtin_amdgcn_permlane32_swap(__float_as_uint(ps), __float_as_uint(ps), false, false); ps = __uint_as_float(rr[0]) + __uint_as_float(rr[1]); }
        l_reg += ps;
        if (IMP) {
            float* imp = (float*)(shm + AT_IMP) + impq * 129 + (kb >> 2) + hi;
#pragma unroll
            for (int j = 0; j < 4; ++j) {
                const float a0 = ((p0[4 * j] + p0[4 * j + 1]) + (p0[4 * j + 2] + p0[4 * j + 3])) * inv_l, b0 = p0[4 * j + 3] * inv_l;
                const float a1 = ((p1[4 * j] + p1[4 * j + 1]) + (p1[4 * j + 2] + p1[4 * j + 3])) * inv_l, b1 = p1[4 * j + 3] * inv_l;
                const int n0 = (kb >> 2) + hi + 2 * j;
                unsigned* impu = (unsigned*)imp;
                atomicAdd(impu + 2 * j, (unsigned)(a0 * 16777216.f + 0.5f)); atomicAdd(impu + 2 * j + 1, (unsigned)(b0 * 16777216.f + 0.5f));
                atomicAdd(impu + 2 * j + 8, (unsigned)(a1 * 16777216.f + 0.5f)); if (n0 + 9 < 128) atomicAdd(impu + 2 * j + 9, (unsigned)(b1 * 16777216.f + 0.5f));
            }
        }
        bf16x8 pa0, pa1, pa2, pa3;
#define PK4(P, B_, OUT) do { unsigned a0_ = cvtpk(P[B_+0], P[B_+1]), a1_ = cvtpk(P[B_+2], P[B_+3]); unsigned b0_ = cvtpk(P[B_+4], P[B_+5]), b1_ = cvtpk(P[B_+6], P[B_+7]); \
        auto r0_ = __builtin_amdgcn_permlane32_swap(a0_, b0_, false, false); auto r1_ = __builtin_amdgcn_permlane32_swap(a1_, b1_, false, false); \
        v4u w_ = {r0_[0], r1_[0], r0_[1], r1_[1]}; OUT = __builtin_bit_cast(bf16x8, w_); } while (0)
        PK4(p0, 0, pa0); PK4(p0, 8, pa1); PK4(p1, 0, pa2); PK4(p1, 8, pa3);
#undef PK4
        SBAR();
        if (!NOPV) pv_pipe<4>(o, vb00 + bo, pa0, pa1, pa2, pa3);
        }
        if (more2) asm volatile("s_waitcnt vmcnt(4) lgkmcnt(0)" ::: "memory"); else asm volatile("s_waitcnt vmcnt(0) lgkmcnt(0)" ::: "memory");
        __builtin_amdgcn_s_barrier(); asm volatile("" ::: "memory");
        kb = kbn; kbn = kbn2; bo = bo >= 65536 ? 0 : bo + 32768;
    }
#undef STAGE
#undef DMA16
}
__device__ __forceinline__ const LAS float* lds_at(char* shm, int off) { asm volatile("" : "+v"(off)); return (const LAS float*)((LAS char*)shm + off); }
typedef GAS unsigned long long gu64;
constexpr int DJ_K = 0, DJ_V = 49152, DJ_P = 114688, DJ_AL = 147456;
static_assert(DJ_AL + 2048 <= LDSCTL_OFF, "diff job LDS map");
__device__ __forceinline__ void diff_job(const bf16* proj, bf16* mix, float* dpart, unsigned* dcnt, const float* __restrict__ dnorm, float lam, int h, int qt, int map, int jlo, char* shm,
                                         volatile LAS unsigned* qw, const int hot = 0) {
    int tid_ = threadIdx.x; asm volatile("" : "+v"(tid_));
    const int tid = tid_, wid = __builtin_amdgcn_readfirstlane(tid >> 6), lane = tid & 63, r32 = lane & 31, hi = lane >> 5;
    const bool prod = wid < 4;
    const int rg = wid & 3, t0 = 128 * qt, t = t0 + 32 * rg + r32, ntiles = 2 * (qt + 1) - jlo;
    const float sl2 = __builtin_amdgcn_exp2f(-(float)(h + 1)) * LOG2E, tref = (float)t0;
    const bf16* Kg = PVEC(proj, OFF_DK + h * 256 + map * 128); const bf16* Vg = PVEC(proj, OFF_DV + h * 256);
    unsigned koff[2], voff[2];
#pragma unroll
    for (int i2 = 0; i2 < 2; ++i2) { const int pk = wid * 2 + i2;
        const int row = 4 * pk + (lane >> 4), c = (lane & 15) ^ (row & 7); koff[i2] = (unsigned)(row * 128 + c * 8) * 2u;
        const int st = 2 * pk + (lane >> 5), pos = lane & 31, kk = (st >> 2) * 8 + (pos >> 2), k = (kk & ~0xC) | ((kk & 4) << 1) | ((kk & 8) >> 1), cv = (st & 3) * 32 + (pos & 3) * 8;
        voff[i2] = (unsigned)(k * 128 + cv) * 2u; }
    LAS unsigned char* lbase = (LAS unsigned char*)shm + wid * 2048;
#define DMA16(gp_, lp_) __builtin_amdgcn_global_load_lds((const unsigned*)(gp_), (LAS unsigned*)(lp_), 16, 0, 0)
#define STAGE_K(kb_, so_) do { const char* kt_ = (const char*)(Kg + (size_t)(kb_) * 128); DMA16(kt_ + koff[0], lbase + DJ_K + (so_)); DMA16(kt_ + koff[1], lbase + DJ_K + (so_) + 1024); } while (0)
#define STAGE_V(kb_, so_) do { const char* vt_ = (const char*)(Vg + (size_t)(kb_) * 128); const char* vt2_ = vt_ + (size_t)SEQ * 256; DMA16(vt_ + voff[0], lbase + DJ_V + (so_)); DMA16(vt_ + voff[1], lbase + DJ_V + (so_) + 1024); \
        DMA16(vt2_ + voff[0], lbase + DJ_V + (so_) + 16384); DMA16(vt2_ + voff[1], lbase + DJ_V + (so_) + 16384 + 1024); } while (0)
    float* alb = (float*)(shm + DJ_AL);
    int wbo_ = DJ_AL + rg * 128 + 16 * hi; asm volatile("" : "+v"(wbo_)); const LAS float* wb = (const LAS float*)((LAS char*)shm + wbo_);
    const int vb00 = (int)(unsigned)(uintptr_t)shm + DJ_V + v_rd_base(lane);
    f32x16 o[8];
    STAGE_K(64 * jlo, 0); if (ntiles > 1) STAGE_K(64 * jlo + 64, AT_KSZ); VM_WAIT(); __syncthreads();
    if (prod) {
        bf16x8 qr[8];
        { const bf16* qrow = PVEC(proj, OFF_DQ + h * 256 + map * 128) + (size_t)t * 128 + hi * 8;
#pragma unroll
          for (int d0 = 0; d0 < 8; ++d0) qr[d0] = *(const bf16x8*)(qrow + d0 * 16); }
        float m_reg = -1e30f, l_reg = 0.f;
        f32x16 pA0, pA1, pB0, pB1; float rfA = 0.f, rfB = 0.f;
#define DJ_QK(P0, P1, RF, ii) do { const int kb_ = 64 * (jlo + (ii)); RF = (m_reg < -1e29f) ? 0.f : m_reg; const float B0_ = sl2 * ((float)(kb_ + 4 * hi) - tref) - RF; \
            _Pragma("unroll") for (int r = 0; r < 16; ++r) { P0[r] = __builtin_fmaf(sl2, (float)((r & 3) + 8 * (r >> 2)), B0_); P1[r] = __builtin_fmaf(sl2, (float)((r & 3) + 8 * (r >> 2) + 32), B0_); } \
            if (hot != 5) qkt_pre<8>(P0, P1, shm + DJ_K + ((ii) % 3) * AT_KSZ, r32, hi, qr); } while (0)
#define DJ_SM(P0, P1, RF, ii) do { if (hot == 6) { asm volatile("" : "+v"(P0), "+v"(P1)); break; } const int kb_ = 64 * (jlo + (ii)); const int d0_ = t - kb_; \
            if (!__all(d0_ >= 63)) { const int dq_ = d0_ - 4 * hi; const float NEG_ = -__builtin_inff(); \
                _Pragma("unroll") for (int r = 0; r < 16; ++r) { const int c_ = (r & 3) + 8 * (r >> 2); if (dq_ - c_ < 0) P0[r] = NEG_; if (dq_ - c_ - 32 < 0) P1[r] = NEG_; } } \
            const bool unset_ = m_reg < -1e29f; const float ref_ = unset_ ? 0.f : m_reg; const float adj_ = ref_ - RF;     \
            float pmax_ = P0[0]; \
            _Pragma("unroll") for (int r = 1; r < 16; ++r) pmax_ = fmaxf(pmax_, P0[r]); \
            _Pragma("unroll") for (int r = 0; r < 16; ++r) pmax_ = fmaxf(pmax_, P1[r]); \
            { auto rr_ = __builtin_amdgcn_permlane32_swap(__float_as_uint(pmax_), __float_as_uint(pmax_), false, false); pmax_ = fmaxf(__uint_as_float(rr_[0]), __uint_as_float(rr_[1])); } \
            pmax_ -= adj_; \
            const bool need_ = unset_ ? (pmax_ > -1e30f) : (pmax_ > 8.0f); \
            float alpha_ = 1.0f; float sub_ = adj_; \
            if (__any(need_)) { alpha_ = (need_ && !unset_) ? __builtin_amdgcn_exp2f(-pmax_) : 1.0f; m_reg = need_ ? ref_ + pmax_ : m_reg; sub_ += need_ ? pmax_ : 0.f; l_reg *= alpha_; } \
            if (__any(sub_ != 0.f)) { _Pragma("unroll") for (int r = 0; r < 16; ++r) { P0[r] -= sub_; P1[r] -= sub_; } } \
            _Pragma("unroll") for (int r = 0; r < 16; ++r) { P0[r] = __builtin_amdgcn_exp2f(P0[r]); P1[r] = __builtin_amdgcn_exp2f(P1[r]); } \
            float ps_ = 0.f; \
            _Pragma("unroll") for (int r = 0; r < 16; ++r) ps_ += P0[r] + P1[r]; \
            { auto rr_ = __builtin_amdgcn_permlane32_swap(__float_as_uint(ps_), __float_as_uint(ps_), false, false); ps_ = __uint_as_float(rr_[0]) + __uint_as_float(rr_[1]); } \
            l_reg += ps_; \
            bf16x8 pa0_, pa1_, pa2_, pa3_; \
            DJ_PK4(P0, 0, pa0_); DJ_PK4(P0, 8, pa1_); DJ_PK4(P1, 0, pa2_); DJ_PK4(P1, 8, pa3_); \
            bf16x8* pb_ = (bf16x8*)(shm + DJ_P + ((ii) & 1) * 16384 + rg * 4096) + lane; \
            pb_[0] = pa0_; pb_[64] = pa1_; pb_[128] = pa2_; pb_[192] = pa3_; \
            if (hi == 0) alb[((ii) & 1) * 128 + rg * 32 + r32] = alpha_; } while (0)
#define DJ_PK4(P, B_, OUT) do { unsigned a0_ = cvtpk(P[B_+0], P[B_+1]), a1_ = cvtpk(P[B_+2], P[B_+3]); unsigned b0_ = cvtpk(P[B_+4], P[B_+5]), b1_ = cvtpk(P[B_+6], P[B_+7]); \
            auto r0_ = __builtin_amdgcn_permlane32_swap(a0_, b0_, false, false); auto r1_ = __builtin_amdgcn_permlane32_swap(a1_, b1_, false, false); \
            v4u w_ = {r0_[0], r1_[0], r0_[1], r1_[1]}; OUT = __builtin_bit_cast(bf16x8, w_); } while (0)
#define DJ_STAGE(ii) do { if (hot < 2) { if ((ii) + 2 < ntiles) STAGE_K(64 * (jlo + (ii) + 2), (((ii) + 2) % 3) * AT_KSZ); if ((ii) < ntiles) STAGE_V(64 * (jlo + (ii)), ((ii) & 1) * 32768); } } while (0)
        DJ_QK(pA0, pA1, rfA, 0);
        int i = 0;
        for (; i + 1 < ntiles; i += 2) {
            DJ_STAGE(i);     DJ_QK(pB0, pB1, rfB, i + 1);                         DJ_SM(pA0, pA1, rfA, i);     VM_WAIT(); __syncthreads();
            DJ_STAGE(i + 1); if (i + 2 < ntiles) DJ_QK(pA0, pA1, rfA, i + 2);     DJ_SM(pB0, pB1, rfB, i + 1); VM_WAIT(); __syncthreads();
        }
        if (i < ntiles) { DJ_STAGE(i); DJ_SM(pA0, pA1, rfA, i); VM_WAIT(); __syncthreads(); ++i; }
        DJ_STAGE(i); VM_WAIT(); __syncthreads();
#undef DJ_QK
#undef DJ_SM
#undef DJ_PK4
        if (hi == 0) alb[256 + rg * 32 + r32] = l_reg;
    } else {
#pragma unroll
        for (int d = 0; d < 8; ++d) o[d] = f32x16{};
        for (int i = 0; i <= ntiles; ++i) {
            const int kb = 64 * (jlo + i);
            DJ_STAGE(i);
            if (i >= 1 && hot != 3) {
                const int sl = (i - 1) & 1;
                { bool any = false; float f[16];
#pragma unroll
                  for (int r = 0; r < 16; ++r) { f[r] = wb[sl * 128 + (r & 3) + 8 * (r >> 2)]; any |= f[r] < 1.f; }
                  if (__any(any)) {
#pragma unroll
                      for (int r = 0; r < 16; ++r)
#pragma unroll
                          for (int d = 0; d < 8; ++d) o[d][r] *= f[r]; } }
                const bf16x8* pb = (const bf16x8*)(shm + DJ_P + sl * 16384 + rg * 4096) + lane;
                bf16x8 pa0 = pb[0], pa1 = pb[64], pa2 = pb[128], pa3 = pb[192];
                asm volatile("" : "+v"(pa0), "+v"(pa1), "+v"(pa2), "+v"(pa3));
                pv_pipe<8>(o, vb00 + sl * 32768, pa0, pa1, pa2, pa3);
            }
            VM_WAIT();
            __syncthreads();
        }
    }
#undef DJ_STAGE
#undef STAGE_K
#undef STAGE_V
#undef DMA16
    __syncthreads();
    const int pair = h * 64 + qt, ctid = tid - 256;
    if (hot) { __syncthreads(); return; }
    if (!prod) {
#pragma unroll
        for (int r = 0; r < 16; ++r) { const float rl = __builtin_amdgcn_rcpf(wb[256 + (r & 3) + 8 * (r >> 2)]);
#pragma unroll
            for (int d = 0; d < 8; ++d) o[d][r] *= rl; }
        const char* mine = (const char*)(dpart + (size_t)(pair * 2 + map) * 32768);
#pragma unroll
        for (int d = 0; d < 8; ++d)
#pragma unroll
            for (int r4 = 0; r4 < 4; ++r4) { gu64* p = (gu64*)(mine + (d * 4 + r4) * 2048) + ctid;
                const unsigned lo = cvtpk(o[d][4 * r4], o[d][4 * r4 + 1]), hi2 = cvtpk(o[d][4 * r4 + 2], o[d][4 * r4 + 3]);
                __hip_atomic_store(p, ((unsigned long long)hi2 << 32) | lo, RLX_AGENT);
                o[d][4 * r4] = __uint_as_float(lo << 16); o[d][4 * r4 + 1] = __uint_as_float(lo & 0xffff0000u); o[d][4 * r4 + 2] = __uint_as_float(hi2 << 16); o[d][4 * r4 + 3] = __uint_as_float(hi2 & 0xffff0000u); }
    }
    asm volatile("s_waitcnt vmcnt(0)" ::: "memory");
    __syncthreads();
    if (tid == 0) qw[1] = __hip_atomic_fetch_add(dcnt + 64 * pair, 1u, __ATOMIC_RELAXED, __HIP_MEMORY_SCOPE_AGENT);
    __syncthreads();
    const unsigned old = (unsigned)__builtin_amdgcn_readfirstlane((int)qw[1]);
    __syncthreads();
    if (old == 0u) return;
    if (!prod) {
        const char* theirs = (const char*)(dpart + (size_t)(pair * 2 + (map ^ 1)) * 32768);
#pragma unroll
        for (int d = 0; d < 8; ++d) {
#pragma unroll
            for (int r4 = 0; r4 < 4; ++r4) { gu64* p = (gu64*)(theirs + (d * 4 + r4) * 2048) + ctid;
                const unsigned long long w = __hip_atomic_load(p, RLX_AGENT); const unsigned lo = (unsigned)w, hi2 = (unsigned)(w >> 32);
                const float p0 = __uint_as_float(lo << 16), p1 = __uint_as_float(lo & 0xffff0000u), p2 = __uint_as_float(hi2 << 16), p3 = __uint_as_float(hi2 & 0xffff0000u);
                const float a0 = o[d][4 * r4], a1 = o[d][4 * r4 + 1], a2 = o[d][4 * r4 + 2], a3 = o[d][4 * r4 + 3];
                o[d][4 * r4] = map ? (p0 - lam * a0) : (a0 - lam * p0); o[d][4 * r4 + 1] = map ? (p1 - lam * a1) : (a1 - lam * p1);
                o[d][4 * r4 + 2] = map ? (p2 - lam * a2) : (a2 - lam * p2); o[d][4 * r4 + 3] = map ? (p3 - lam * a3) : (a3 - lam * p3); }
            asm volatile("" : "+v"(o[d]) :: "memory"); }
        float gn[8];
#pragma unroll
        for (int d = 0; d < 8; ++d) gn[d] = dnorm[32 * d + r32] * (1.0f - LAM0);
#pragma unroll
        for (int r = 0; r < 16; ++r) { float s = 0.f;
#pragma unroll
            for (int d = 0; d < 8; ++d) s += o[d][r] * o[d][r];
            s += swz_xor<1>(s); s += swz_xor<2>(s); s += swz_xor<4>(s); s += swz_xor<8>(s); s += swz_xor<16>(s);
            const float sc = 1.0f / sqrtf(s * (1.0f / 256.0f) + EPS);
            bf16* orow = mix + (size_t)(t0 + 32 * rg + crow(r, hi)) * DM + h * 256 + r32;
#pragma unroll
            for (int d = 0; d < 8; ++d) { const float v = o[d][r] * sc * gn[d]; const float vn = dpp_xor1(v);
                if ((r32 & 1) == 0) *(unsigned*)(orow + 32 * d) = cvtpk(v, vn); } }
    }
    __syncthreads();
}
__device__ __forceinline__ void norm_pass(const bf16* proj, float* slots, int bx, int G, char* shm) {
    const int tid = threadIdx.x, wave = tid >> 6, ln = tid & 63, v = ln >> 1, half = ln & 1;
    float mx = 0.f;
    for (int t = bx * NWAVES + wave; t < SEQ; t += G * NWAVES) {
        const v4u* p = (const v4u*)(PVEC(proj, v * 128) + (size_t)t * 128 + half * 64);
        float s = 0.f;
#pragma unroll
        for (int i = 0; i < 8; ++i) { const v4u w = p[i];
            const float a0 = __uint_as_float(w.x << 16), a1 = __uint_as_float(w.x & 0xffff0000u), a2 = __uint_as_float(w.y << 16), a3 = __uint_as_float(w.y & 0xffff0000u);
            const float a4 = __uint_as_float(w.z << 16), a5 = __uint_as_float(w.z & 0xffff0000u), a6 = __uint_as_float(w.w << 16), a7 = __uint_as_float(w.w & 0xffff0000u);
            s += (a0 * a0 + a1 * a1) + (a2 * a2 + a3 * a3) + (a4 * a4 + a5 * a5) + (a6 * a6 + a7 * a7); }
        s += dpp_xor1(s);
        mx = fmaxf(mx, s);
    }
    float* red = (float*)shm;
    if (half == 0) red[wave * 32 + v] = mx;
    __syncthreads();
    if (tid < 32) { float m = red[tid];
#pragma unroll
        for (int w = 1; w < NWAVES; ++w) m = fmaxf(m, red[w * 32 + tid]);
        slots[bx * 32 + tid] = sqrtf(m) * 1.004f; }
    __syncthreads();
}
__device__ __forceinline__ void nsa_unit(const bf16* proj, const bf16* kc, const bf16* vc, bf16* mix, float* scr, const float* __restrict__ gate_bias, int hkv, int qt, char* shm, const int probe = 0) {
    int tid_ = threadIdx.x; asm volatile("" : "+v"(tid_));
    const int tid = tid_, wid = __builtin_amdgcn_readfirstlane(tid >> 6), lane = tid & 63, r32 = lane & 31, hi = lane >> 5;
    const int g = wid & 3, qs = wid >> 2, t0 = 64 * qt, q = 32 * qs + r32, t = t0 + q, head = hkv * 4 + g;
    int* list = (int*)(shm + AT_LIST);
    float* wsf = (float*)(shm + AT_WS) + wid * 64;
    float* gates = (float*)(shm + AT_GATE);
    float* imp = (float*)(shm + AT_IMP);
    unsigned* uni = (unsigned*)(shm + AT_UNI);
    unsigned short* selm16 = (unsigned short*)(shm + AT_SELM);
    const float slope = __builtin_amdgcn_exp2f(-0.5f * (float)(head + 1));
    for (int i = tid; i < 64 * 129; i += 512) imp[i] = 0.f;
    if (tid < 8) uni[tid] = 0u;
    for (int i = tid; i < 768; i += 512) { const int qq = i / 12, rem = i - qq * 12;
        const float v = bf2f(PVEC(proj, OFF_G)[(size_t)(t0 + qq) * 128 + hkv * 12 + rem]) + gate_bias[hkv * 12 + rem];
        gates[i] = __builtin_amdgcn_rcpf(1.0f + __builtin_amdgcn_exp2f(-LOG2E * v)); }
    const int ntc = ((t0 + 32) >> 10) + 1;
    if (tid < ntc) list[tid] = 64 * tid;
    __syncthreads();
    bf16x8 qr[8];
    { const bf16* qrow = PVEC(proj, OFF_NQ + head * 128) + (size_t)t * 128 + hi * 8;
#pragma unroll
      for (int d0 = 0; d0 < 8; ++d0) qr[d0] = *(const bf16x8*)(qrow + d0 * 16); }
    f32x16 o[4];
    float rf[16];
    const LAS float* wb = lds_at(shm, AT_WS + wid * 256 + 16 * hi);
    const LAS float* gb = lds_at(shm, AT_GATE + ((32 * qs + 4 * hi) * 12 + g * 3) * 4);
    {
        AttnP a; a.Kg = kc + (size_t)hkv * 512 * HD; a.Vg = vc + (size_t)hkv * 512 * HD; a.ldk = HD; a.ntiles = ntc; a.tq = (t >= 31) ? ((t - 31) >> 4) : -1; a.W = 0x7fffffffu;
        a.sl2 = 16.0f * slope * LOG2E; a.tref = ((float)t0 - 31.0f) * (1.0f / 16.0f);
#pragma unroll
        for (int d = 0; d < 4; ++d) o[d] = f32x16{};
        float m_reg = -1e30f, l_reg = 0.f;
        if (!(probe & 1)) attn_run<false, false, true>(shm, a, qr, o, m_reg, l_reg, 0, 0.f, 0);
        const float inv_l = l_reg > 0.f ? 1.0f / l_reg : 0.f;
#pragma unroll
        for (int d = 0; d < 4; ++d) o[d] = f32x16{};
        float l2 = 0.f;
        if (!(probe & 2)) { if (probe & 32) attn_run<false, false>(shm, a, qr, o, m_reg, l2, 0, inv_l, q); else attn_run<true, false>(shm, a, qr, o, m_reg, l2, 0, inv_l, q); }
        if (hi == 0) wsf[r32] = inv_l; LDS_WAIT();
#pragma unroll
        for (int r = 0; r < 16; ++r) rf[r] = wb[(r & 3) + 8 * (r >> 2)] * gb[12 * ((r & 3) + 8 * (r >> 2)) + 0];
        LDS_WAIT();
#pragma unroll
        for (int d = 0; d < 4; ++d)
#pragma unroll
            for (int r = 0; r < 16; ++r) scr[tid * 128 + d * 16 + r] = o[d][r] * rf[r];
    }
    {
        const int qq = tid >> 3, part = tid & 7;
        float s[16];
#pragma unroll
        for (int e = 0; e < 16; ++e) { const int n = part * 16 + e; const float v = (float)((const unsigned*)imp)[qq * 129 + n] * (1.0f / 16777216.f);
            s[e] = (n == 0 || n == qt || n == qt - 1) ? 1e4f : (n <= qt ? v : -1.0f); }
        __syncthreads();
#pragma unroll
        for (int e = 0; e < 16; ++e) imp[qq * 129 + part * 16 + e] = s[e];
        __syncthreads();
        unsigned bits = 0u;
        if (qt < 16) { if (part == 0) bits = (2u << qt) - 1u; }
        else {
            unsigned key[16];
#pragma unroll
            for (int e = 0; e < 16; ++e) key[e] = s[e] < 0.f ? 0u : __float_as_uint(s[e]) + 1u;
            unsigned T = 0u;
#pragma unroll 1
            for (int bit = 31; bit >= 0; --bit) { const unsigned c = T | (1u << bit); int cnt = 0;
#pragma unroll
                for (int e = 0; e < 16; ++e) cnt += key[e] >= c ? 1 : 0;
                cnt += __builtin_amdgcn_mov_dpp(cnt, 0xB1, 0xF, 0xF, true); cnt += __builtin_amdgcn_mov_dpp(cnt, 0x4E, 0xF, 0xF, true);
                cnt += __builtin_amdgcn_ds_swizzle(cnt, (4 << 10) | 0x1f);
                if (cnt >= 16) T = c; }
            int cgt = 0, ceq = 0;
#pragma unroll
            for (int e = 0; e < 16; ++e) { cgt += key[e] > T ? 1 : 0; ceq += key[e] == T ? 1 : 0; }
            cgt += __builtin_amdgcn_mov_dpp(cgt, 0xB1, 0xF, 0xF, true); cgt += __builtin_amdgcn_mov_dpp(cgt, 0x4E, 0xF, 0xF, true); cgt += __builtin_amdgcn_ds_swizzle(cgt, (4 << 10) | 0x1f);
            int pre = ceq;
            { const int l8 = tid & 7; int t1 = __shfl_up(pre, 1, 8); if (l8 >= 1) pre += t1; int t2 = __shfl_up(pre, 2, 8); if (l8 >= 2) pre += t2; int t4 = __shfl_up(pre, 4, 8); if (l8 >= 4) pre += t4; }
            int run = pre - ceq; const int need = 16 - cgt;
#pragma unroll
            for (int e = 0; e < 16; ++e) { const bool eq = key[e] == T; if (key[e] > T || (eq && run < need)) bits |= 1u << e; run += eq ? 1 : 0; }
        }
        selm16[qq * 8 + part] = (unsigned short)bits;
        if (bits) atomicOr(&uni[part >> 1], bits << (16 * (part & 1)));
        __syncthreads();
        if (tid < 128) {
            const unsigned u0 = uni[0], u1 = uni[1], u2 = uni[2], u3 = uni[3]; const int w = tid >> 5, b = tid & 31;
            const unsigned uw = w == 0 ? u0 : (w == 1 ? u1 : (w == 2 ? u2 : u3));
            if ((uw >> b) & 1u) { int pos = __popc(uw & ((1u << b) - 1u)); if (w > 0) pos += __popc(u0); if (w > 1) pos += __popc(u1); if (w > 2) pos += __popc(u2); list[pos] = 64 * tid; }
            if (tid == 0) uni[4] = (unsigned)(__popc(u0) + __popc(u1) + __popc(u2) + __popc(u3)); }
        __syncthreads();
    }
    {
        AttnP a; a.Kg = PVEC(proj, OFF_KS + hkv * HD); a.Vg = PVEC(proj, OFF_VS + hkv * HD); a.ldk = 128; a.ntiles = (int)uni[4]; a.tq = t; a.W = 0x7fffffffu; a.sl2 = slope * LOG2E; a.tref = (float)t0;
#pragma unroll
        for (int d = 0; d < 4; ++d) o[d] = f32x16{};
        float m_reg = -1e30f, l_reg = 0.f;
        if (!(probe & 4)) attn_run<false, true>(shm, a, qr, o, m_reg, l_reg, 0, 0.f, q);
        if (hi == 0) wsf[r32] = l_reg; LDS_WAIT();
#pragma unroll
        for (int r = 0; r < 16; ++r) rf[r] = __builtin_amdgcn_rcpf(wb[(r & 3) + 8 * (r >> 2)]) * gb[12 * ((r & 3) + 8 * (r >> 2)) + 1];
        LDS_WAIT();
#pragma unroll
        for (int d = 0; d < 4; ++d)
#pragma unroll
            for (int r = 0; r < 16; ++r) scr[tid * 128 + d * 16 + r] += o[d][r] * rf[r];
    }
    {
        const int jlo = qt >= 8 ? qt - 8 : 0, nw = qt - jlo + 1;
        if (tid < nw) list[tid] = 64 * (jlo + tid);
        __syncthreads();
        AttnP a; a.Kg = PVEC(proj, OFF_KW + hkv * HD); a.Vg = PVEC(proj, OFF_VW + hkv * HD); a.ldk = 128; a.ntiles = nw; a.tq = t; a.W = 512u; a.sl2 = slope * LOG2E; a.tref = (float)t0;
#pragma unroll
        for (int d = 0; d < 4; ++d) o[d] = f32x16{};
        float m_reg = -1e30f, l_reg = 0.f;
        if (!(probe & 8)) attn_run<false, false>(shm, a, qr, o, m_reg, l_reg, 0, 0.f, 0);
        if (probe) { __syncthreads(); return; }
        if (hi == 0) wsf[r32] = l_reg; LDS_WAIT();
#pragma unroll
        for (int r = 0; r < 16; ++r) rf[r] = __builtin_amdgcn_rcpf(wb[(r & 3) + 8 * (r >> 2)]) * gb[12 * ((r & 3) + 8 * (r >> 2)) + 2];
        LDS_WAIT();
#pragma unroll
        for (int r = 0; r < 16; ++r) { bf16* orow = mix + (size_t)(t0 + 32 * qs + crow(r, hi)) * DM + 2048 + head * 128 + r32;
#pragma unroll
            for (int d = 0; d < 4; ++d) { const float v = scr[tid * 128 + d * 16 + r] + o[d][r] * rf[r]; const float vn = dpp_xor1(v);
                if ((r32 & 1) == 0) *(unsigned*)(orow + 32 * d) = cvtpk(v, vn); } }
    }
    __syncthreads();
}
#ifndef STOP_AFTER
#define STOP_AFTER -1
#endif
#ifndef DUMP_OFF
#define DUMP_OFF 0
#endif
#ifndef REP_P0
#define REP_P0 1
#endif
#ifndef REP_P1
#define REP_P1 1
#endif
#ifndef REP_P5
#define REP_P5 1
#endif
#ifndef REP_DIFF
#define REP_DIFF 1
#endif
#ifndef REP_NSA
#define REP_NSA 1
#endif
#ifndef REP_ONLY
#define REP_ONLY 0
#endif
constexpr int ITEMS_FF = (DM / 64) * (DFF / 64), ITEMS_IN = (DM / 64) * ((NIN + 63) / 64), TAIL_UP2 = ITEMS_FF, TAIL_DN2 = ITEMS_FF, TAIL_GT2 = 5888, TAIL_DN9 = ITEMS_FF, TAIL_DN1 = ITEMS_FF, TAIL_IN1 = 0;
__device__ __forceinline__ void dbg_dump(int k, int off, float* out, const bf16* UB, const bf16* PROJ, const bf16* KC, int gw, int ngw) {
    const int ln = threadIdx.x & 63;
    if (k == 3 || k == 6) { for (size_t i = (size_t)gw * 64 + ln; i < (size_t)SEQ * DM; i += (size_t)ngw * 64) out[i] = bf2f(UB[i]); }
    else if (k == 4) { for (size_t i = (size_t)gw * 64 + ln; i < (size_t)SEQ * DM; i += (size_t)ngw * 64) { const size_t m = i / DM, n = i % DM; out[i] = bf2f(PVEC(PROJ, (off + n) & ~127)[m * 128 + ((off + n) & 127)]); } }
    else if (k == 5) { for (size_t i = (size_t)gw * 64 + ln; i < (size_t)SEQ * DM; i += (size_t)ngw * 64) out[i] = bf2f(KC[i & 524287]); }
}
struct Args { const float* in[25]; float* out; unsigned char* ws; int stop_after; int dump_off; };
__global__ void __launch_bounds__(NWAVES * 64, 2) mk_fwd(Args args) {
    extern __shared__ __attribute__((aligned(16))) unsigned char lds[];
    LAS unsigned char* ldsl = (LAS unsigned char*)lds;
    const int tid = threadIdx.x, wave = __builtin_amdgcn_readfirstlane(tid >> 6);
#define lane ((int)(threadIdx.x & 63u))
    const int G = gridDim.x, bx = blockIdx.x, vcu = (G % 8 == 0) ? (bx % 8) * (G / 8) + bx / 8 : bx;
    const int gw = vcu * NWAVES + wave, ngw = G * NWAVES;
    unsigned char* ws = args.ws;
    gu32* ctl = (gu32*)(ws + WS_CTL);
    for (int u = tid; u < (LDS_BYTES - LDSCTL_OFF) / 4; u += NWAVES * 64) ((LAS unsigned*)(ldsl + LDSCTL_OFF))[u] = 0u;
    __syncthreads();
    XcdBarrier bar = xcd_barrier_post((unsigned*)(ctl + CW_BAR), (volatile LAS unsigned*)(ldsl + MISC_OFF) + 8);
    float* h = args.out;
    bf16* UB = (bf16*)(ws + WS_UB); bf16* HID = (bf16*)(ws + WS_HID); bf16* PROJ = (bf16*)(ws + WS_HID);
    bf16* KC = (bf16*)(ws + WS_KC); bf16* VC = (bf16*)(ws + WS_VC);
    float* scr = (float*)(ws + WS_SCR) + (size_t)bx * 65536;
    const int stop = args.stop_after;
#define SEAM(k) do { xcd_barrier(bar); if (stop == (k)) { dbg_dump((k), args.dump_off, h, UB, PROJ, KC, gw, ngw); return; } } while (0)

#ifndef NO_P0
    for (int rep_ = 0; rep_ < REP_P0; ++rep_) {
        LAS float* tscr = (LAS float*)(ldsl + wave * 16640);
        tr_matrix(args.in[2], DM, DFF, (bf16*)(ws + WS_WGU1), 1, tscr, gw, ngw, lane, 2);
        tr_matrix(args.in[3], DM, DFF, (bf16*)(ws + WS_WGU1), 2, tscr, gw, ngw, lane, 2);
        tr_range(args.in[4], DFF, DM, (bf16*)(ws + WS_WD1), 0, tscr, TAIL_DN1, ITEMS_FF, gw, ngw, lane, 1);
        tr_range(args.in[6], DM, NIN, (bf16*)(ws + WS_WIN), 0, tscr, TAIL_IN1, ITEMS_IN, gw, ngw, lane, 2);
        tr_range(args.in[23], DFF, DM, (bf16*)(ws + WS_WD2), 0, tscr, TAIL_DN2, ITEMS_FF, gw, ngw, lane, 1);
        tile_w1(args.in[14], (bf16*)(ws + WS_W1K), gw, ngw, lane);
        tile_w1(args.in[17], (bf16*)(ws + WS_W1V), gw, ngw, lane);
        tr_matrix(args.in[15], 256, 128, (bf16*)(ws + WS_W2K), 0, tscr, gw, ngw, lane, 0);
        tr_matrix(args.in[18], 256, 128, (bf16*)(ws + WS_W2V), 0, tscr, gw, ngw, lane, 0);
        rms_rows_bf16(args.in[0], args.in[1], UB, gw, ngw, lane);
    }
#endif
    SEAM(0);
#ifndef NO_GEMM
    for (int rep_ = 0; rep_ < REP_P1; ++rep_) {
        pg8::Gemm g{UB, (const bf16*)(ws + WS_WGU1), SEQ, 2 * DFF, DM, 0, 1}; pg8::StaticOrder S; S.init(SEQ, 2 * DFF, G, bx);
        pg8::EpiSwiGLU E{HID, DFF, 1};
        pg8::gemm_phase<pg8::EpiSwiGLU, pg8::StaticOrder, true, true>(ldsl, g, S, E);
        { constexpr int NU = (SEQ / 256) * (2 * DFF / 256); const int nfull = NU % G;
          const int tw_ = nfull ? (bx - nfull) * NWAVES + wave : gw, tn_ = nfull ? (G - nfull) * NWAVES : ngw;
          if (rep_ == 0 && (!nfull || bx >= nfull)) { tr_range(args.in[4], DFF, DM, (bf16*)(ws + WS_WD1), 0, (LAS float*)(ldsl + wave * 16640), 0, TAIL_DN1, tw_, tn_, lane, 1);
              tr_range(args.in[6], DM, NIN, (bf16*)(ws + WS_WIN), 0, (LAS float*)(ldsl + wave * 16640), 0, TAIL_IN1, tw_, tn_, lane, 2); } }
    }
#endif
    SEAM(1);
#ifndef NO_GEMM
    {
        pg8::Gemm g{HID, (const bf16*)(ws + WS_WD1), SEQ, DM, DFF, 1, 1}; pg8::StaticOrder S; S.init(SEQ, DM, G, bx);
        pg8::EpiResF32 E{args.in[0], h, DM, 0.5f};
        pg8::gemm_phase<pg8::EpiResF32, pg8::StaticOrder, true, true>(ldsl, g, S, E);
    }
#endif
    SEAM(2);
    rms_rows_bf16(h, args.in[5], UB, gw, ngw, lane);
    SEAM(3);
#ifndef NO_GEMM
    {
        pg8::Gemm g{UB, (const bf16*)(ws + WS_WIN), SEQ, LDP, DM, 0, 1}; pg8::StaticOrder S; S.init(SEQ, LDP, G, bx);
        pg8::EpiProj E{PROJ, LDP, OFF_DQ, OFF_DK, OFF_NQ, OFF_KC, QSCALE};
        pg8::gemm_phase<pg8::EpiProj, pg8::StaticOrder, true, true>(ldsl, g, S, E);
        { constexpr int NU = (SEQ / 256) * (LDP / 256); const int nfull = NU % G;
          const int tw_ = nfull ? (bx - nfull) * NWAVES + wave : gw, tn_ = nfull ? (G - nfull) * NWAVES : ngw;
          if (!nfull || bx >= nfull) { tr_range(args.in[22], DM, DFF, (bf16*)(ws + WS_WGU2), 2, (LAS float*)(ldsl + wave * 16640), 0, TAIL_UP2, tw_, tn_, lane, 2);
              tr_range(args.in[21], DM, DFF, (bf16*)(ws + WS_WGU2), 1, (LAS float*)(ldsl + wave * 16640), TAIL_GT2, ITEMS_FF, tw_, tn_, lane, 2); } }
    }
#endif
    SEAM(4);
    norm_pass(PROJ, (float*)(ctl + CW_NORM), bx, G, (char*)lds);
    const bool split8 = (G == 256);
    const int xcd5 = bx & 7, slot5 = bx >> 3;
    const int ctask = split8 ? (slot5 < 16 ? (xcd5 >> 2) * 64 + (xcd5 & 3) * 16 + slot5 : 128) : vcu;
    const int cstep = split8 ? 128 : G;
#ifndef NO_CMP
    for (int rep_ = 0; rep_ < REP_P5; ++rep_)
    for (int task = ctask; task < 128; task += cstep) {
        const int kv = task >> 6, rb = task & 63;
        compress_task(PROJ, kv ? OFF_VC : OFF_KC, kv ? args.in[16] : args.in[13], (const bf16*)(ws + (kv ? WS_W1V : WS_W1K)), (const bf16*)(ws + (kv ? WS_W2V : WS_W2K)), kv ? VC : KC, rb,
                      (char*)lds, wave, lane);
    }
#endif
    if (split8 ? slot5 >= 16 : (vcu >= 128 || G <= 128)) {
        const int tw5_ = split8 ? ((slot5 - 16) * 8 + xcd5) * NWAVES + wave : (G > 128 ? (vcu - 128) * NWAVES + wave : gw), tn5_ = split8 ? 128 * NWAVES : (G > 128 ? (G - 128) * NWAVES : ngw);
        tr_range(args.in[23], DFF, DM, (bf16*)(ws + WS_WD2), 0, (LAS float*)(ldsl + wave * 16640), TAIL_DN9, TAIL_DN2, tw5_, tn5_, lane, 1);
        tr_range(args.in[21], DM, DFF, (bf16*)(ws + WS_WGU2), 1, (LAS float*)(ldsl + wave * 16640), 0, TAIL_GT2, tw5_, tn5_, lane, 2);
        tr_range(args.in[19], DM, DM, (bf16*)(ws + WS_WOUT), 0, (LAS float*)(ldsl + wave * 16640), 0, (DM / 64) * (DM / 64), tw5_, tn5_, lane, 1); }
    SEAM(5);
    {
        float lam;
        { const float a1 = wave_sum(args.in[8][lane] * args.in[9][lane] + args.in[8][lane + 64] * args.in[9][lane + 64]);
          const float a2 = wave_sum(args.in[10][lane] * args.in[11][lane] + args.in[10][lane + 64] * args.in[11][lane + 64]);
          lam = __expf(a1) - __expf(a2) + LAM0; }
        float* dcutL = (float*)((char*)lds + LDSCTL_OFF + 768);
        { float m = 0.f; const float* slots = (const float*)(ctl + CW_NORM);
          for (int w = tid >> 5; w < G; w += 16) m = fmaxf(m, slots[w * 32 + (tid & 31)]);
          float* red = (float*)lds; red[tid] = m; __syncthreads();
          if (tid < 32) { float mm = red[tid];
#pragma unroll
              for (int p = 1; p < 16; ++p) mm = fmaxf(mm, red[p * 32 + tid]);
              red[512 + tid] = mm; }
          __syncthreads();
          if (tid < 8) { const float qm = fmaxf(red[512 + 2 * tid], red[513 + 2 * tid]), km = fmaxf(red[528 + 2 * tid], red[529 + 2 * tid]);
              dcutL[tid] = (2.0f * qm * km + 70.0f) / (__builtin_amdgcn_exp2f(-(float)(tid + 1)) * LOG2E); }
          __syncthreads();
          unsigned char* segL = (unsigned char*)lds + LDSCTL_OFF + 512;
          if (tid == 0) {
              float* W = (float*)((char*)lds + 4096); int* ord = (int*)((char*)lds + 4160); float* load = (float*)((char*)lds + 4224); int* ns = (int*)((char*)lds + 4256);
              for (int s = 0; s < 16; ++s) { const float dc = dcutL[s >> 1]; int w = 0;
                  for (int qq = 0; qq < 64; ++qq) { const float fl = ((float)(128 * qq) - dc) * (1.0f / 64.0f); w += 2 * (qq + 1) - (fl > 0.f ? (int)fl : 0); }
                  W[s] = (float)w; ord[s] = s; }
              for (int a = 0; a < 16; ++a) for (int b = a + 1; b < 16; ++b) if (W[ord[b]] > W[ord[a]]) { const int t_ = ord[a]; ord[a] = ord[b]; ord[b] = t_; }
              for (int x = 0; x < 8; ++x) { load[x] = 0.f; ns[x] = 0; }
              for (int a = 0; a < 16; ++a) { int bx_ = 0; for (int x = 1; x < 8; ++x) if (load[x] < load[bx_]) bx_ = x;
                  segL[bx_ * 16 + ns[bx_]] = (unsigned char)ord[a]; ns[bx_]++; load[bx_] += W[ord[a]]; }
              for (int x = 0; x < 8; ++x) segL[128 + x] = (unsigned char)ns[x];
          }
          __syncthreads(); }
        volatile LAS unsigned* qw = (volatile LAS unsigned*)(ldsl + MISC_OFF) + 12;
        const int myx = (int)(xb_xcc_id() & 7u);
        for (int rep_ = 0; rep_ < REP_DIFF; ++rep_) {
#pragma unroll 1
        for (int dx = 0; dx < 8; ++dx) {
            const int x = (myx + dx) & 7;
            const int nsg = __builtin_amdgcn_readfirstlane((int)((unsigned char*)lds + LDSCTL_OFF + 512)[128 + x]), len = 64 * nsg + 64;
#pragma unroll 1
            for (;;) {
                if (tid == 0) qw[0] = __hip_atomic_fetch_add((unsigned*)(ctl + CW_QUEUE) + 64 * (8 * rep_ + x), 1u, __ATOMIC_RELAXED, __HIP_MEMORY_SCOPE_AGENT);
                __syncthreads();
                const int u = __builtin_amdgcn_readfirstlane((int)qw[0]);
                __syncthreads();
                if (u >= len) break;
                if (u >= 64) {
#ifndef NO_DIFF
                    if (rep_ >= 1 && (REP_ONLY == 2 || REP_ONLY >= 64)) continue;
                    const int st = __builtin_amdgcn_readfirstlane((int)((unsigned char*)lds + LDSCTL_OFF + 512)[x * 16 + ((u - 64) >> 6)]), hh = st >> 1, qt = 63 - (u & 63);
                    const float fl = ((float)(128 * qt) - dcutL[hh]) * (1.0f / 64.0f);
                    const int jlo = __builtin_amdgcn_readfirstlane(fl > 0.f ? (int)fl : 0);
                    diff_job(PROJ, UB, (float*)(ws + WS_DPART), (unsigned*)(ctl + CW_DCNT) + 32768 * rep_, args.in[12], lam, hh, qt, st & 1, jlo, (char*)lds, qw, (rep_ >= 1 && REP_ONLY >= 3) ? REP_ONLY - 2 : 0);
#endif
                } else {
#ifndef NO_NSA
                    if (rep_ >= 1 && (REP_ONLY == 1 || (REP_ONLY >= 3 && REP_ONLY < 64))) continue;
                    const int j = u;
                    nsa_unit(PROJ, KC, VC, UB, scr, args.in[7], x >> 1, 127 - 2 * j - (x & 1), (char*)lds, (rep_ >= 1 && REP_ONLY >= 64) ? REP_ONLY - 64 : 0);
#endif
                }
            }
        } }
    }
    SEAM(6);
#ifndef NO_GEMM
    {
        pg8::Gemm g{UB, (const bf16*)(ws + WS_WOUT), SEQ, DM, DM, 0, 1}; pg8::StaticOrder S; S.init(SEQ, DM, G, bx);
        pg8::EpiResF32 E{h, h, DM, 1.0f};
        pg8::gemm_phase<pg8::EpiResF32, pg8::StaticOrder, true, true>(ldsl, g, S, E);
    }
#endif
    SEAM(7);
    rms_rows_bf16(h, args.in[20], UB, gw, ngw, lane);
    SEAM(8);
#ifndef NO_GEMM
    {
        pg8::Gemm g{UB, (const bf16*)(ws + WS_WGU2), SEQ, 2 * DFF, DM, 0, 1}; pg8::StaticOrder S; S.init(SEQ, 2 * DFF, G, bx);
        pg8::EpiSwiGLU E{HID, DFF, 1};
        pg8::gemm_phase<pg8::EpiSwiGLU, pg8::StaticOrder, true, true>(ldsl, g, S, E);
        { constexpr int NU = (SEQ / 256) * (2 * DFF / 256); const int nfull = NU % G;
          const int tw_ = nfull ? (bx - nfull) * NWAVES + wave : gw, tn_ = nfull ? (G - nfull) * NWAVES : ngw;
          if (!nfull || bx >= nfull) tr_range(args.in[23], DFF, DM, (bf16*)(ws + WS_WD2), 0, (LAS float*)(ldsl + wave * 16640), 0, TAIL_DN9, tw_, tn_, lane, 1); }
    }
#endif
    SEAM(9);
#ifndef NO_GEMM
    {
        pg8::Gemm g{HID, (const bf16*)(ws + WS_WD2), SEQ, DM, DFF, 1, 1}; pg8::StaticOrder S; S.init(SEQ, DM, G, bx);
        pg8::EpiResF32 E{h, h, DM, 0.5f};
        pg8::gemm_phase<pg8::EpiResF32, pg8::StaticOrder, true, true>(ldsl, g, S, E);
    }
#endif
    SEAM(10);
    rms_rows_f32(h, args.in[24], gw, ngw, lane);
#undef SEAM
#undef lane
}

extern "C" void kernel_launch(void* const* d_in, const int* in_sizes, int n_in, void* d_out, int out_size, void* d_ws, size_t ws_size, hipStream_t stream) {
    static int grid = 0;
    if (grid == 0) {
        if (n_in != 25 || in_sizes[0] != SEQ * DM || out_size != SEQ * DM || ws_size < WS_END) {
            fprintf(stderr, "kernel_launch: built for 25 inputs, x/out of %d floats, >= %zu bytes of workspace; got n_in %d, in0 %d, out %d, ws %zu; nothing launched\n", SEQ * DM, (size_t)WS_END, n_in, n_in > 0 ? in_sizes[0] : -1, out_size, ws_size);
            grid = -1; return; }
        int dev = 0, cus = 0, per_cu = 0;
        if (hipGetDevice(&dev) != hipSuccess || hipDeviceGetAttribute(&cus, hipDeviceAttributeMultiprocessorCount, dev) != hipSuccess) { fprintf(stderr, "kernel_launch: device query failed\n"); grid = -1; return; }
        if (hipFuncSetAttribute((const void*)mk_fwd, hipFuncAttributeMaxDynamicSharedMemorySize, LDS_BYTES) != hipSuccess) { fprintf(stderr, "kernel_launch: hipFuncSetAttribute failed\n"); grid = -1; return; }
        if (hipOccupancyMaxActiveBlocksPerMultiprocessor(&per_cu, (const void*)mk_fwd, NWAVES * 64, LDS_BYTES) != hipSuccess || per_cu < 1)
            fprintf(stderr, "kernel_launch: note: occupancy query reports %d workgroups per CU\n", per_cu);
        (void)hipGetLastError();
        grid = cus;
    }
    if (grid < 0) return;
    if (hipMemsetAsync((char*)d_ws + WS_CTL, 0, CTL_ZERO_BYTES, stream) != hipSuccess) { fprintf(stderr, "kernel_launch: memset failed\n"); return; }
    Args a{};
    for (int i = 0; i < 25; ++i) a.in[i] = (const float*)d_in[i];
    a.out = (float*)d_out; a.ws = (unsigned char*)d_ws; a.stop_after = STOP_AFTER; a.dump_off = DUMP_OFF;
    hipLaunchKernelGGL(mk_fwd, dim3(grid), dim3(NWAVES * 64), LDS_BYTES, stream, a);
    const hipError_t le = hipPeekAtLastError();
    if (le != hipSuccess) fprintf(stderr, "kernel_launch: launch failed: %s\n", hipGetErrorName(le));
}
```

```cpp
#include <hip/hip_runtime.h>
#include <cstdio>
#include <cstdint>
#ifndef DBG_STAGE
#define DBG_STAGE 0
#endif
namespace pg8 {
#define PG8_LAS __attribute__((address_space(3)))
typedef unsigned short bf16_t;
typedef short bf16x8 __attribute__((ext_vector_type(8)));
typedef float f32x4 __attribute__((ext_vector_type(4)));
typedef unsigned u32x4 __attribute__((ext_vector_type(4)));
constexpr int BM = 256, BK = 64, HALF = 128, HTB = HALF * BK * 2  , STAGE_BYTES = 8 * HTB, NXCD = 8, WGM = 8;

__host__ __device__ __forceinline__ int lds_byte(int r, int c) { const int st = (r >> 4) * 2 + (c >> 5), rr = r & 15, cc = c & 31, ob = rr * 64 + cc * 2; return st * 1024 + (ob ^ (((ob >> 9) & 1) << 5)); }
__host__ __device__ __forceinline__ void stage_rc(int b, int& R, int& C) { const int st = b / 1024, sb = b % 1024, swz = sb ^ (((sb >> 9) & 1) << 5); R = (st >> 1) * 16 + swz / 64; C = (st & 1) * 32 + (swz % 64) / 2; }
__host__ __device__ __forceinline__ int perm32(int rho) { const int n = rho >> 4, i = rho & 15; return 8 * (i >> 2) + 4 * n + (i & 3); }

struct Unit { int pm, pn; };
struct Gemm { const bf16_t* A; const bf16_t* Bt; int M, N, K; int imgA = 0, imgB = 0; };

struct StaticOrder {
    int nM, nN, nwg, G, c;
    __host__ __device__ void init(int M, int N, int G_, int c_) { nM = M / BM; nN = N / BM; nwg = nM * nN; G = G_; c = c_; }
    __host__ __device__ bool next(int i, Unit& u) const {
        const long L = (long)i * G + c; if (L >= nwg) return false;
        int wgid = (int)L; { const int q = nwg / NXCD, r = nwg % NXCD, xcd = wgid % NXCD, off = wgid / NXCD; wgid = (xcd < r ? xcd * (q + 1) : r * (q + 1) + (xcd - r) * q) + off; }
        const int nig = WGM * nN, gid = wgid / nig, fm = gid * WGM, gsz = (nM - fm) < WGM ? (nM - fm) : WGM;
        u.pm = fm + ((wgid % nig) % gsz); u.pn = (wgid % nig) / gsz; return true;
    }
    __device__ __forceinline__ void a_ready(const Unit&) const {}
    __device__ __forceinline__ void done(const Unit&) const {}
};
typedef float f32x2c_t __attribute__((ext_vector_type(2))); typedef __bf16 bf16x2c_t __attribute__((ext_vector_type(2)));
__device__ __forceinline__ unsigned cvt_pk_bf16(float lo, float hi) { f32x2c_t v = {lo, hi}; bf16x2c_t b = __builtin_convertvector(v, bf16x2c_t); return __builtin_bit_cast(unsigned, b); }
typedef float f32x2 __attribute__((ext_vector_type(2)));
struct EpiSwiGLU {
    static constexpr bool PERM = true, AFTER_DRAIN = false;
    bf16_t* O; int ldc; int img;
    __device__ __forceinline__ void operator()(const f32x4 (&acc)[2][2][4][2], const Unit& u, int wr, int wc, int fr, int fq) const {
        const int row0 = u.pm * BM + wr * 64 + fr, col0 = u.pn * HALF + wc * 32 + 8 * fq;
        const int ntk = ldc >> 6;
#pragma unroll
        for (int ai = 0; ai < 2; ++ai)
#pragma unroll
            for (int m = 0; m < 4; ++m) { bf16_t* rowp = img ? (bf16_t*)((char*)O + ((size_t)(u.pm * 2 + ai) * ntk + (col0 >> 6)) * 16384 + lds_byte(wr * 64 + m * 16 + fr, col0 & 63))
                                                    : O + (size_t)(row0 + ai * HALF + m * 16) * ldc + col0;
                float v[8];
#pragma unroll
                for (int n = 0; n < 2; ++n)
#pragma unroll
                    for (int j = 0; j < 4; ++j) { const float g = acc[ai][0][m][n][j], up = acc[ai][1][m][n][j];
                        const float e = __builtin_amdgcn_exp2f(g * -1.4426950408889634f); v[4 * n + j] = g * __builtin_amdgcn_rcpf(1.0f + e) * up; }
                u32x4 w; w.x = cvt_pk_bf16(v[0], v[1]); w.y = cvt_pk_bf16(v[2], v[3]); w.z = cvt_pk_bf16(v[4], v[5]); w.w = cvt_pk_bf16(v[6], v[7]);
                *(u32x4*)rowp = w; }
    }
};
struct EpiResF32 {
    static constexpr bool PERM = false, AFTER_DRAIN = false;
    const float* base; float* out; int ldc; float alpha;
    __device__ __forceinline__ void operator()(const f32x4 (&acc)[2][2][4][2], const Unit& u, int wr, int wc, int fr, int fq) const {
        const int row0 = u.pm * BM + wr * 64 + fr, col0 = u.pn * BM + wc * 32 + 4 * fq;
#pragma unroll
        for (int ai = 0; ai < 2; ++ai)
#pragma unroll
            for (int m = 0; m < 4; ++m) { const size_t off = (size_t)(row0 + ai * HALF + m * 16) * ldc + col0;
#pragma unroll
                for (int bj = 0; bj < 2; ++bj)
#pragma unroll
                    for (int n = 0; n < 2; ++n) { const f32x4 b = *(const f32x4*)(base + off + bj * HALF + n * 16); *(f32x4*)(out + off + bj * HALF + n * 16) = b + acc[ai][bj][m][n] * alpha; }
                asm volatile("" ::: "memory"); }
    }
};
struct EpiProj {
    static constexpr bool PERM = true, AFTER_DRAIN = false;
    bf16_t* O; int ldc; int q0a, q0b, q1a, q1b; float qscale;
    __device__ __forceinline__ void operator()(const f32x4 (&acc)[2][2][4][2], const Unit& u, int wr, int wc, int fr, int fq) const {
        const int row0 = u.pm * BM + wr * 64 + fr, colt = u.pn * BM, col0 = colt + wc * 32 + 8 * fq;
        const float sc = ((colt >= q0a && colt < q0b) || (colt >= q1a && colt < q1b)) ? qscale : 1.0f;
#pragma unroll
        for (int ai = 0; ai < 2; ++ai)
#pragma unroll
            for (int m = 0; m < 4; ++m) { bf16_t* rowp = O + (size_t)(colt >> 7) * ((size_t)8192 * 128) + (size_t)(row0 + ai * HALF + m * 16) * 128 + wc * 32 + 8 * fq;
#pragma unroll
                for (int bj = 0; bj < 2; ++bj) { const f32x4 v0 = acc[ai][bj][m][0] * sc, v1 = acc[ai][bj][m][1] * sc;
                    u32x4 w; w.x = cvt_pk_bf16(v0[0], v0[1]); w.y = cvt_pk_bf16(v0[2], v0[3]); w.z = cvt_pk_bf16(v1[0], v1[1]); w.w = cvt_pk_bf16(v1[2], v1[3]);
                    *(u32x4*)(rowp + (size_t)bj * ((size_t)8192 * 128)) = w; } }
    }
};
template <class Epi, class Sched, bool ALIGN_EPI = false, bool SP2 = false>
__device__ __forceinline__ void gemm_phase(PG8_LAS unsigned char* lds, const Gemm g, const Sched& S, const Epi& E) {
    int tid_ = threadIdx.x; asm volatile("" : "+v"(tid_));
    const int tid = tid_, wid = __builtin_amdgcn_readfirstlane(tid >> 6), lane = tid & 63, wr = wid >> 2, wc = wid & 3, fr = lane & 15, fq = lane >> 4;
    const int K = g.K, nt = K / BK;
    unsigned voffA[2], voffB[2];
#pragma unroll
    for (int i = 0; i < 2; ++i) { int R, C; stage_rc(tid * 16 + i * 8192, R, C); const int Rb = Epi::PERM ? ((R & ~31) + perm32(R & 31)) : R;
        voffA[i] = g.imgA ? (unsigned)(tid * 16 + i * 8192) : (unsigned)(R * K + C) * 2u; voffB[i] = g.imgB ? (unsigned)(tid * 16 + i * 8192) : (unsigned)(Rb * K + C) * 2u; }
    const size_t kstA = g.imgA ? (size_t)HTB : (size_t)(BK * 2), kstB = g.imgB ? (size_t)HTB : (size_t)(BK * 2);
    const size_t hstA = g.imgA ? (size_t)HTB * nt : (size_t)HALF * K * 2, hstB = g.imgB ? (size_t)HTB * nt : (size_t)HALF * K * 2;
    const size_t tstA = 2 * hstA, tstB = 2 * hstB;
    const unsigned ldsw = (unsigned)wid * 1024u;
    const int aoff = lds_byte(wr * 64 + fr, fq * 8), boff = lds_byte(wc * 32 + fr, fq * 8);
#define PG8_SA(b, h) (((b) * 2 + (h)) * HTB)
#define PG8_SB(b, h) ((4 + (b) * 2 + (h)) * HTB)
#define PG8_STAGE(bufoff, gbase, voff) do { _Pragma("unroll") for (int _i = 0; _i < 2; ++_i) \
        __builtin_amdgcn_global_load_lds((const unsigned*)((const char*)(gbase) + (voff)[_i]), (PG8_LAS unsigned*)(lds + (bufoff) + ldsw + _i * 8192), 16, 0, 0); } while (0)
#define PG8_LDA(dst, b, h) do { _Pragma("unroll") for (int m = 0; m < 4; ++m) _Pragma("unroll") for (int k = 0; k < 2; ++k) dst[m][k] = *(const PG8_LAS bf16x8*)(lds + PG8_SA(b, h) + aoff + m * 2048 + k * 1024); } while (0)
#define PG8_LDB(dst, b, h) do { _Pragma("unroll") for (int n = 0; n < 2; ++n) _Pragma("unroll") for (int k = 0; k < 2; ++k) dst[n][k] = *(const PG8_LAS bf16x8*)(lds + PG8_SB(b, h) + boff + n * 2048 + k * 1024); } while (0)
#define PG8_MMA(ai, bj, At, Bt) do { __builtin_amdgcn_s_setprio(1); _Pragma("unroll") for (int m = 0; m < 4; ++m) _Pragma("unroll") for (int n = 0; n < 2; ++n) _Pragma("unroll") for (int k = 0; k < 2; ++k) \
        acc[ai][bj][m][n] = __builtin_amdgcn_mfma_f32_16x16x32_bf16(Bt[n][k], At[m][k], acc[ai][bj][m][n], 0, 0, 0); __builtin_amdgcn_s_setprio(0); } while (0)
#define PG8_WAIT_V(n) asm volatile("s_waitcnt vmcnt(" #n ")" ::: "memory")
#define PG8_WAIT_L(n) asm volatile("s_waitcnt lgkmcnt(" #n ")" ::: "memory")
#define PG8_BAR __builtin_amdgcn_s_barrier()
#define PG8_SCHED __builtin_amdgcn_sched_barrier(0)
    Unit cur, nxt; int ui = 0;
    if (!S.next(0, cur)) return;
    f32x4 acc[2][2][4][2];
#pragma unroll
    for (int a = 0; a < 2; ++a)
#pragma unroll
        for (int b = 0; b < 2; ++b)
#pragma unroll
            for (int m = 0; m < 4; ++m)
#pragma unroll
                for (int n = 0; n < 2; ++n) acc[a][b][m][n] = (f32x4){0.f, 0.f, 0.f, 0.f};
    bf16x8 At[4][2], B0[2][2], B1[2][2];
    const char* cA = (const char*)g.A + (size_t)cur.pm * tstA; const char* cB = (const char*)g.Bt + (size_t)cur.pn * tstB;
    S.a_ready(cur);
    if constexpr (SP2) {
        PG8_STAGE(PG8_SB(0, 0), cB, voffB); PG8_STAGE(PG8_SB(0, 1), cB + hstB, voffB); PG8_STAGE(PG8_SA(0, 0), cA, voffA); PG8_STAGE(PG8_SA(0, 1), cA + hstA, voffA);
        if (wr == 1) PG8_BAR;
        PG8_WAIT_V(2); PG8_BAR;
        PG8_STAGE(PG8_SB(1, 0), cB + kstB, voffB); PG8_STAGE(PG8_SA(1, 0), cA + kstA, voffA); PG8_STAGE(PG8_SB(1, 1), cB + hstB + kstB, voffB);
        PG8_WAIT_V(6); PG8_BAR;
    } else {
        PG8_STAGE(PG8_SB(0, 0), cB, voffB); PG8_STAGE(PG8_SA(0, 0), cA, voffA); PG8_STAGE(PG8_SB(0, 1), cB + hstB, voffB); PG8_STAGE(PG8_SA(0, 1), cA + hstA, voffA);
        if (wr == 1) PG8_BAR;
        PG8_WAIT_V(4); PG8_BAR;
        PG8_STAGE(PG8_SB(1, 0), cB + kstB, voffB); PG8_STAGE(PG8_SA(1, 0), cA + kstA, voffA); PG8_STAGE(PG8_SB(1, 1), cB + hstB + kstB, voffB);
        PG8_WAIT_V(6); PG8_BAR;
    }
    for (;;) {
        const bool has_next = S.next(ui + 1, nxt);
        const char* nA = has_next ? (const char*)g.A + (size_t)nxt.pm * tstA : cA; const char* nB = has_next ? (const char*)g.Bt + (size_t)nxt.pn * tstB : cB;
        for (int t = 0; t < nt; t += 2) {
            const bool last = (t == nt - 2);
            const char* a1 = cA + (size_t)(t + 1) * kstA;
            const char* a2 = last ? nA : cA + (size_t)(t + 2) * kstA; const char* b2 = last ? nB : cB + (size_t)(t + 2) * kstB;
            const char* a3 = a2 + kstA; const char* b3 = b2 + kstB;
            if (last && has_next) S.a_ready(nxt);
            if constexpr (SP2) {
            PG8_LDB(B0, 0, 0); PG8_LDB(B1, 0, 1); PG8_SCHED; PG8_LDA(At, 0, 0); PG8_STAGE(PG8_SA(1, 1), a1 + hstA, voffA);
            PG8_WAIT_V(8); PG8_WAIT_L(0); PG8_BAR; PG8_MMA(0, 0, At, B0); PG8_MMA(0, 1, At, B1); PG8_BAR; PG8_SCHED;
            PG8_LDA(At, 0, 1); PG8_STAGE(PG8_SB(0, 0), b2, voffB); PG8_STAGE(PG8_SB(0, 1), b2 + hstB, voffB); PG8_STAGE(PG8_SA(0, 0), a2, voffA);
            PG8_WAIT_V(8); PG8_WAIT_L(0); PG8_BAR; PG8_MMA(1, 0, At, B0); PG8_MMA(1, 1, At, B1); PG8_BAR; PG8_SCHED;
            PG8_LDB(B0, 1, 0); PG8_LDB(B1, 1, 1); PG8_SCHED; PG8_LDA(At, 1, 0); PG8_STAGE(PG8_SA(0, 1), a2 + hstA, voffA);
            PG8_WAIT_V(8); PG8_WAIT_L(0); PG8_BAR; PG8_MMA(0, 0, At, B0); PG8_MMA(0, 1, At, B1); PG8_BAR; PG8_SCHED;
            PG8_LDA(At, 1, 1); PG8_STAGE(PG8_SB(1, 0), b3, voffB); PG8_STAGE(PG8_SB(1, 1), b3 + hstB, voffB); PG8_STAGE(PG8_SA(1, 0), a3, voffA);
            PG8_WAIT_V(8); PG8_WAIT_L(0); PG8_BAR; PG8_MMA(1, 0, At, B0); PG8_MMA(1, 1, At, B1); PG8_BAR; PG8_SCHED;
            } else {
            PG8_LDB(B0, 0, 0); PG8_SCHED; PG8_LDA(At, 0, 0); PG8_STAGE(PG8_SA(1, 1), a1 + hstA, voffA);
            PG8_WAIT_L(8); PG8_BAR; PG8_WAIT_L(0); PG8_MMA(0, 0, At, B0); PG8_BAR; PG8_SCHED;
            PG8_LDB(B1, 0, 1); PG8_STAGE(PG8_SB(0, 0), b2, voffB);
            PG8_BAR; PG8_WAIT_L(0); PG8_MMA(0, 1, At, B1); PG8_BAR;
            PG8_LDA(At, 0, 1); PG8_STAGE(PG8_SA(0, 0), a2, voffA);
            PG8_BAR; PG8_WAIT_L(0); PG8_MMA(1, 0, At, B0); PG8_BAR; PG8_SCHED;
            PG8_STAGE(PG8_SB(0, 1), b2 + hstB, voffB);
            PG8_WAIT_V(6); PG8_BAR; PG8_MMA(1, 1, At, B1); PG8_BAR;
            PG8_LDB(B0, 1, 0); PG8_SCHED; PG8_LDA(At, 1, 0); PG8_STAGE(PG8_SA(0, 1), a2 + hstA, voffA);
            PG8_WAIT_L(8); PG8_BAR; PG8_WAIT_L(0); PG8_MMA(0, 0, At, B0); PG8_BAR; PG8_SCHED;
            PG8_LDB(B1, 1, 1); PG8_STAGE(PG8_SB(1, 0), b3, voffB);
            PG8_BAR; PG8_WAIT_L(0); PG8_MMA(0, 1, At, B1); PG8_BAR;
            PG8_LDA(At, 1, 1); PG8_STAGE(PG8_SA(1, 0), a3, voffA);
            PG8_BAR; PG8_WAIT_L(0); PG8_MMA(1, 0, At, B0); PG8_BAR; PG8_SCHED;
            PG8_STAGE(PG8_SB(1, 1), b3 + hstB, voffB);
            PG8_WAIT_V(6); PG8_BAR; PG8_MMA(1, 1, At, B1); PG8_BAR;
            }
        }
        if constexpr (ALIGN_EPI) { if (wr == 0) PG8_BAR; }
        if constexpr (!Epi::AFTER_DRAIN) { E(acc, cur, wr, wc, fr, fq); S.done(cur); }
        if (!has_next) break;
#pragma unroll
        for (int a = 0; a < 2; ++a)
#pragma unroll
            for (int b = 0; b < 2; ++b)
#pragma unroll
                for (int m = 0; m < 4; ++m)
#pragma unroll
                    for (int n = 0; n < 2; ++n) acc[a][b][m][n] = (f32x4){0.f, 0.f, 0.f, 0.f};
        cur = nxt; cA = nA; cB = nB; ++ui;
        if constexpr (ALIGN_EPI) { if (wr == 1) PG8_BAR; }
    }
    PG8_WAIT_V(0);
    if constexpr (!ALIGN_EPI) { if (wr == 0) PG8_BAR; }
    PG8_BAR;
    if constexpr (Epi::AFTER_DRAIN) { E.fused(acc, cur, wr, wc, fr, fq, lds, wid, lane); S.done(cur); }
#undef PG8_SA
#undef PG8_SB
#undef PG8_STAGE
#undef PG8_LDA
#undef PG8_LDB
#undef PG8_MMA
#undef PG8_WAIT_V
#undef PG8_WAIT_L
#undef PG8_BAR
#undef PG8_SCHED
}
}
constexpr int SEQ = 8192, DM = 4096, DFF = 11008, NIN = 11312, LDP = 11520;
constexpr int HD = 128, DIFF_H = 8, NSA_H = 16, NSA_KV = 4;
constexpr int OFF_DQ = 0, OFF_DK = 2048, OFF_DV = 4096, OFF_NQ = 6144, OFF_KC = 8192, OFF_VC = 8704, OFF_KS = 9216, OFF_VS = 9728, OFF_KW = 10240, OFF_VW = 10752, OFF_G = 11264;
#define PVEC(p, col) ((p) + (size_t)((col) >> 7) * ((size_t)SEQ * 128))
constexpr float EPS = 1e-6f, LOG2E = 1.4426950408889634f, QSCALE = 0.08838834764831845f * 1.4426950408889634f;
constexpr float LAM0 = 0.2f;
constexpr int NWAVES = 8;
constexpr size_t MiB = 1u << 20;
constexpr size_t WS_CTL = 0, CTL_ZERO_BYTES = 1 * MiB;
constexpr size_t WS_SCR = 922 * MiB;
constexpr size_t WS_KC = 34 * MiB, WS_VC = WS_KC + 512 * 1024;
constexpr size_t WS_W1K = 35 * MiB, WS_W1V = 37 * MiB, WS_W2K = 39 * MiB, WS_W2V = WS_W2K + 65536;
constexpr size_t WS_WOUT = 40 * MiB, WS_WIN = 72 * MiB, WS_WGU1 = 162 * MiB, WS_WD1 = 334 * MiB, WS_WGU2 = 420 * MiB, WS_WD2 = 592 * MiB;
constexpr size_t WS_UB = 678 * MiB;
constexpr size_t WS_HID = 742 * MiB;
constexpr size_t WS_DPART = 986 * MiB;
constexpr size_t WS_END = 1114 * MiB;
constexpr int CW_DBG = 64;
constexpr int CW_QUEUE = 1024;
constexpr int CW_NORM = 16384;
constexpr int CW_DCNT = 65536;
constexpr int CW_RSS1 = 131072, CW_RSS2 = 139264;
constexpr int CW_BAR = 4096;
constexpr int RING_BYTES = 131072;
constexpr int AT_BUFSZ = 49152, AT_KSZ = 16384, AT_WS = 98304, AT_LIST = 100352, AT_GATE = 101440, AT_SELM = 104512, AT_UNI = 105536, AT_IMP = 105600, AT_SS = 138624, AT_ORD = 139648, AT_END = 140736;
constexpr int LDSCTL_OFF = 151552, MISC_OFF = LDSCTL_OFF + 320, LDS_BYTES = 155648;
static_assert(AT_END <= LDSCTL_OFF && MISC_OFF + 128 <= LDS_BYTES, "LDS map");

#define GAS __attribute__((address_space(1)))
#define LAS __attribute__((address_space(3)))
typedef unsigned short bf16;
typedef unsigned v4u __attribute__((ext_vector_type(4)));
typedef unsigned v2u __attribute__((ext_vector_type(2)));
typedef float f32x4 __attribute__((ext_vector_type(4)));
typedef float f32x16 __attribute__((ext_vector_type(16)));
typedef short bf16x8 __attribute__((ext_vector_type(8)));
typedef short s16x4 __attribute__((ext_vector_type(4)));
typedef GAS unsigned gu32;
#define RLX_AGENT __ATOMIC_RELAXED, __HIP_MEMORY_SCOPE_AGENT
#define LDS_WAIT() asm volatile("s_waitcnt lgkmcnt(0)" ::: "memory")
#define VM_WAIT() asm volatile("s_waitcnt vmcnt(0)" ::: "memory")
#define SBAR() __builtin_amdgcn_sched_barrier(0)
typedef float f32x2_t __attribute__((ext_vector_type(2))); typedef __bf16 bf16x2_t __attribute__((ext_vector_type(2)));
__device__ __forceinline__ unsigned cvtpk(float lo, float hi) { f32x2_t v = {lo, hi}; bf16x2_t b = __builtin_convertvector(v, bf16x2_t); return __builtin_bit_cast(unsigned, b); }
__device__ __forceinline__ float bf2f(unsigned short b) { return __uint_as_float(((unsigned)b) << 16); }
template <int K> __device__ __forceinline__ float swz_xor(float v) { return __int_as_float(__builtin_amdgcn_ds_swizzle(__float_as_int(v), (K << 10) | 0x1f)); }
__device__ __forceinline__ float dpp_xor1(float v) { return __int_as_float(__builtin_amdgcn_mov_dpp(__float_as_int(v), 0xB1, 0xF, 0xF, true)); }
__device__ __forceinline__ float wave_sum(float v) {
#pragma unroll
    for (int o = 1; o < 64; o <<= 1) v += __shfl_xor(v, o);
    return v;
}
#define XB_TMO      128
#define XB_XCNT(j)  (256  + 64 * (j))
#define XB_XSUB(j)  (1280 + 64 * (j))
#define XB_XGEN(j)  (2304 + 64 * (j))
#define XB_TOP      3328
#define XB_TOPGEN   3392
#define XCD_BAR_WORDS 3456
#define XB_SPIN_CAP (1u << 18)

__device__ __forceinline__ unsigned xb_ld(unsigned* p)              { return __hip_atomic_load(p, __ATOMIC_RELAXED, __HIP_MEMORY_SCOPE_AGENT); }
__device__ __forceinline__ unsigned xb_add(unsigned* p, unsigned v) { return __hip_atomic_fetch_add(p, v, __ATOMIC_RELAXED, __HIP_MEMORY_SCOPE_AGENT); }
__device__ __forceinline__ unsigned xb_xcc_id() { return (unsigned)__builtin_amdgcn_s_getreg((3 << 11) | 20) & 0xFu; }
#define XB_SPIN(cond, bar) do { unsigned _sp = 0; while (cond) { __builtin_amdgcn_s_sleep(1); \
    if ((++_sp & 255u) == 0u) { if (xb_ld(&(bar)[XB_TMO])) break; if (_sp > XB_SPIN_CAP) { atomicAdd(&(bar)[XB_TMO], 1u); break; } } } } while (0)

struct XcdBarrier {
    unsigned* bar; unsigned x;
    volatile LAS unsigned* st;
};

__device__ __forceinline__ XcdBarrier xcd_barrier_post(unsigned* bar, volatile LAS unsigned* st) {
    XcdBarrier b; b.bar = bar; b.x = xb_xcc_id(); b.st = st;
    if (threadIdx.x == 0) (void)xb_add(&bar[XB_XCNT(b.x)], 1u);
    return b;
}
__device__ __forceinline__ void xcd_barrier_complete(unsigned* bar, unsigned x, unsigned& nloc, unsigned& nx) {
    const unsigned G = gridDim.x * gridDim.y * gridDim.z;
    unsigned sum, cnt, mine, sp = 0u;
    for (;;) {
        sum = 0u; cnt = 0u; mine = 0u;
#pragma unroll
        for (unsigned j = 0; j < 16; ++j) { const unsigned c = xb_ld(&bar[XB_XCNT(j)]); sum += c; cnt += (c > 0u) ? 1u : 0u; mine = (j == x) ? c : mine; }
        if (sum == G) break;
        __builtin_amdgcn_s_sleep(1);
        if ((++sp & 255u) == 0u) { if (xb_ld(&bar[XB_TMO])) break; if (sp > XB_SPIN_CAP) { atomicAdd(&bar[XB_TMO], 1u); break; } }
    }
    nloc = mine > 0u ? mine : 1u; nx = cnt > 0u ? cnt : 1u;
}

__device__ __forceinline__ void xcd_barrier(const XcdBarrier& b) {
    asm volatile("s_waitcnt vmcnt(0)" ::: "memory");
    __syncthreads();
    if (threadIdx.x == 0) {
        unsigned* bar = b.bar;
        __builtin_amdgcn_s_waitcnt(0);
        unsigned nloc = b.st[0], nx = b.st[1];
        if (nloc == 0u) { xcd_barrier_complete(bar, b.x, nloc, nx); b.st[0] = nloc; b.st[1] = nx; }
        const unsigned old = xb_add(&bar[XB_XSUB(b.x)], 1u);
        const unsigned gen = old / nloc;
        if (old + 1u == (gen + 1u) * nloc) {
            __builtin_amdgcn_fence(__ATOMIC_RELEASE, "agent");
            asm volatile("s_waitcnt vmcnt(0)" ::: "memory");
            const unsigned og = xb_add(&bar[XB_TOP], 1u);
            const unsigned tg = og / nx;
            if (og + 1u == (tg + 1u) * nx) xb_add(&bar[XB_TOPGEN], 1u);
            else XB_SPIN(xb_ld(&bar[XB_TOPGEN]) == tg, bar);
            __builtin_amdgcn_fence(__ATOMIC_ACQUIRE, "agent");
            xb_add(&bar[XB_XGEN(b.x)], 1u);
            asm volatile("s_waitcnt vmcnt(0)" ::: "memory");
        } else {
            XB_SPIN(xb_ld(&bar[XB_XGEN(b.x)]) == gen, bar);
            __builtin_amdgcn_fence(__ATOMIC_ACQUIRE, "agent");
            asm volatile("s_waitcnt vmcnt(0)" ::: "memory");
        }
    }
    __syncthreads();
}
__device__ __forceinline__ int inv_perm32(int v) { return 16 * ((v >> 2) & 1) + 4 * (v >> 3) + (v & 3); }
__device__ __forceinline__ void tr_load(const float* __restrict__ W, int N, int item, int lane, f32x4 (&v)[16]) {
    const int nnb = (N + 63) >> 6, kb = item / nnb, nb = item - kb * nnb, k0 = kb * 64, n0 = nb * 64;
    const int c4 = (lane & 15) * 4, col = (n0 + c4 + 3 < N) ? n0 + c4 : 0;
    const float* p = W + (size_t)(k0 + (lane >> 4)) * N + col;
#pragma unroll
    for (int q = 0; q < 16; ++q) v[q] = *(const GAS f32x4*)(p + (size_t)(4 * q) * N);
}
__device__ __forceinline__ void tr_store(const f32x4 (&v)[16], int K, int N, bf16* WT, int mode, LAS float* scr, int item, int lane, int img) {
    const int nnb = (N + 63) >> 6, kb = item / nnb, nb = item - kb * nnb, k0 = kb * 64, n0 = nb * 64;
    { LAS float* w = scr + (lane >> 4) * 65 + (lane & 15) * 4;
#pragma unroll
      for (int q = 0; q < 16; ++q) { w[(4 * q) * 65 + 0] = v[q].x; w[(4 * q) * 65 + 1] = v[q].y; w[(4 * q) * 65 + 2] = v[q].z; w[(4 * q) * 65 + 3] = v[q].w; } }
    LDS_WAIT(); asm volatile("" ::: "memory");
    const int c = lane & 7;
    const int drow0 = (mode == 0) ? n0 : (256 * (n0 >> 7) + (n0 & 127) + (mode == 2 ? 128 : 0));
#pragma unroll
    for (int j = 0; j < 8; ++j) { const int nn = (lane >> 3) + 8 * j; const LAS float* s = scr + (8 * c) * 65 + nn;
        v4u o; o.x = cvtpk(s[0], s[65]); o.y = cvtpk(s[130], s[195]); o.z = cvtpk(s[260], s[325]); o.w = cvtpk(s[390], s[455]);
        if (n0 + nn < N) { const int drow = drow0 + nn;
            if (img == 0) *(GAS v4u*)(WT + (size_t)drow * K + k0 + 8 * c) = o;
            else { const int r128 = drow & 127, rho = (img == 2) ? ((r128 & ~31) + inv_perm32(r128 & 31)) : r128;
                   *(GAS v4u*)((char*)WT + ((size_t)(drow >> 7) * (K >> 6) + kb) * 16384 + pg8::lds_byte(rho, 8 * c)) = o; } } }
    LDS_WAIT(); asm volatile("" ::: "memory");
}
__device__ __forceinline__ void tr_range(const float* __restrict__ W, int K, int N, bf16* WT, int mode, LAS float* scr, int lo, int hi, int w, int nw, int lane, int img) {
    int it = lo + w;
    if (it >= hi) return;
    f32x4 va[16], vb[16];
    tr_load(W, N, it, lane, va);
    for (;;) {
        const int n1 = it + nw;
        if (n1 < hi) tr_load(W, N, n1, lane, vb);
        tr_store(va, K, N, WT, mode, scr, it, lane, img);
        if (n1 >= hi) break;
        const int n2 = n1 + nw;
        if (n2 < hi) tr_load(W, N, n2, lane, va);
        tr_store(vb, K, N, WT, mode, scr, n1, lane, img);
        if (n2 >= hi) break;
        it = n2;
    }
}
__device__ __forceinline__ void tr_matrix(const float* __restrict__ W, int K, int N, bf16* WT, int mode, LAS float* scr, int gw, int ngw, int lane, int img = 0) {
    tr_range(W, K, N, WT, mode, scr, 0, (K >> 6) * ((N + 63) >> 6), gw, ngw, lane, img);
}
__device__ __forceinline__ void tile_w1(const float* __restrict__ W1, bf16* W1f, int gw, int ngw, int lane) {
    const int r32 = lane & 31, hi = lane >> 5;
    for (int f = gw; f < 256 * 8; f += ngw) { const int step = f >> 3, cb = f & 7;
        const float* s = W1 + (size_t)(16 * step + 8 * hi) * 256 + 32 * cb + r32;
        v4u o; o.x = cvtpk(s[0], s[256]); o.y = cvtpk(s[512], s[768]); o.z = cvtpk(s[1024], s[1280]); o.w = cvtpk(s[1536], s[1792]);
        *(GAS v4u*)(W1f + ((size_t)f * 64 + lane) * 8) = o; }
}
__device__ __forceinline__ void rms_rows_bf16(const float* X, const float* __restrict__ g, bf16* O, int gw, int ngw, int lane) {
    for (int m = gw; m < SEQ; m += ngw) {
        const GAS f32x4* xr = (const GAS f32x4*)(X + (size_t)m * DM) + lane;
        f32x4 v[16]; float s = 0.f;
#pragma unroll
        for (int j = 0; j < 16; ++j) { v[j] = xr[64 * j]; s += (v[j].x * v[j].x + v[j].y * v[j].y) + (v[j].z * v[j].z + v[j].w * v[j].w); }
        const float rstd = 1.0f / sqrtf(wave_sum(s) * (1.0f / DM) + EPS);
        GAS v2u* o8 = (GAS v2u*)(O + (size_t)m * DM) + lane;
#pragma unroll
        for (int j = 0; j < 16; ++j) { const f32x4 gv = ((const f32x4*)g)[lane + 64 * j]; v2u w; w.x = cvtpk(v[j].x * rstd * gv.x, v[j].y * rstd * gv.y); w.y = cvtpk(v[j].z * rstd * gv.z, v[j].w * rstd * gv.w); o8[64 * j] = w; }
    }
}
__device__ __forceinline__ void rms_rows_f32(float* X, const float* __restrict__ g, int gw, int ngw, int lane) {
    for (int m = gw; m < SEQ; m += ngw) {
        GAS f32x4* xr = (GAS f32x4*)(X + (size_t)m * DM) + lane;
        f32x4 v[16]; float s = 0.f;
#pragma unroll
        for (int j = 0; j < 16; ++j) { v[j] = xr[64 * j]; s += (v[j].x * v[j].x + v[j].y * v[j].y) + (v[j].z * v[j].z + v[j].w * v[j].w); }
        const float rstd = 1.0f / sqrtf(wave_sum(s) * (1.0f / DM) + EPS);
#pragma unroll
        for (int j = 0; j < 16; ++j) { const f32x4 gv = ((const f32x4*)g)[lane + 64 * j]; xr[64 * j] = v[j] * rstd * gv; }
    }
}
__device__ __forceinline__ int crow(int r, int hi) { return (r & 3) + 8 * (r >> 2) + 4 * hi; }
__device__ __forceinline__ void compress_task(const bf16* proj, int off_kv, const float* __restrict__ pos, const bf16* __restrict__ W1t, const bf16* __restrict__ W2t, bf16* outc, int rb,
                                              char* shm, int wave, int lane) {
    const int r32 = lane & 31, hi = lane >> 5, tid = wave * 64 + lane;
    const int h = rb >> 4, c = ((rb & 15) << 5) + r32, ce = c < 511 ? c : 510;
    float* hsum = (float*)(shm + 32768);
    for (int i = tid; i < 32 * 256; i += 512) hsum[i] = 0.f;
    f32x16 acc[8];
#pragma unroll
    for (int cb = 0; cb < 8; ++cb) acc[cb] = f32x16{};
    const bf16* arow = PVEC(proj, off_kv + h * HD) + (size_t)(16 * ce + 4 * wave) * 128 + hi * 8;
    const float* prow = pos + (4 * wave) * HD + hi * 8;
    const bf16* bfrag = W1t + ((size_t)(32 * wave) * 8 * 64 + lane) * 8;
#pragma unroll 1
    for (int l = 0; l < 4; ++l) {
#pragma unroll 2
        for (int j = 0; j < 8; ++j) {
            const v4u av = *(const v4u*)(arow + (size_t)l * 128 + 16 * j);
            const f32x4 p0 = *(const f32x4*)(prow + l * HD + 16 * j), p1 = *(const f32x4*)(prow + l * HD + 16 * j + 4);
            bf16x8 bv[8];
#pragma unroll
            for (int cb = 0; cb < 8; ++cb) bv[cb] = *(const bf16x8*)(bfrag + (size_t)(((l * 8 + j) * 8 + cb) * 64) * 8);
            v4u aw;
            aw.x = cvtpk(__uint_as_float(av.x << 16) + p0.x, __uint_as_float(av.x & 0xffff0000u) + p0.y);
            aw.y = cvtpk(__uint_as_float(av.y << 16) + p0.z, __uint_as_float(av.y & 0xffff0000u) + p0.w);
            aw.z = cvtpk(__uint_as_float(av.z << 16) + p1.x, __uint_as_float(av.z & 0xffff0000u) + p1.y);
            aw.w = cvtpk(__uint_as_float(av.w << 16) + p1.z, __uint_as_float(av.w & 0xffff0000u) + p1.w);
            const bf16x8 af = __builtin_bit_cast(bf16x8, aw);
#pragma unroll
            for (int cb = 0; cb < 8; ++cb) acc[cb] = __builtin_amdgcn_mfma_f32_32x32x16_bf16(af, bv[cb], acc[cb], 0, 0, 0);
        }
    }
    __syncthreads();
#pragma unroll
    for (int cb = 0; cb < 8; ++cb)
#pragma unroll
        for (int r = 0; r < 16; ++r) atomicAdd((int*)hsum + crow(r, hi) * 256 + 32 * cb + r32, (int)rintf(acc[cb][r] * 65536.f));
    __syncthreads();
    bf16* hid = (bf16*)shm;
    for (int i = tid; i < 32 * 256; i += 512) { const float x = (float)((const int*)hsum)[i] * (1.0f / 65536.f); const float y = 1.5957691216057308f * (x + 0.044715f * x * x * x);
        const float gl = x * __builtin_amdgcn_rcpf(1.0f + __builtin_amdgcn_exp2f(-LOG2E * y));
        hid[(i >> 8) * 264 + (i & 255)] = (bf16)(cvtpk(gl, 0.f) & 0xffffu); }
    __syncthreads();
    if (wave < 4) {
        f32x16 a2 = {};
        const bf16* b2 = W2t + (size_t)(32 * wave + r32) * 256 + hi * 8;
#pragma unroll
        for (int kk = 0; kk < 16; ++kk) {
            const bf16x8 af = *(const bf16x8*)(hid + r32 * 264 + 16 * kk + hi * 8);
            const bf16x8 bv = *(const bf16x8*)(b2 + 16 * kk);
            a2 = __builtin_amdgcn_mfma_f32_32x32x16_bf16(af, bv, a2, 0, 0, 0);
        }
#pragma unroll
        for (int r = 0; r < 16; ++r) { const int cr = ((rb & 15) << 5) + crow(r, hi);
            outc[((size_t)h * 512 + cr) * HD + 32 * wave + r32] = (cr < 511) ? (bf16)(cvtpk(a2[r], 0.f) & 0xffffu) : (bf16)0; }
    }
    __syncthreads();
}
#define KSWZ(row, colB) ((row) * 256 + ((colB) ^ (((row) & 7) << 4)))
__device__ __forceinline__ int v_st(int k, int c) { const int kk = (k & ~0xC) | ((k & 4) << 1) | ((k & 8) >> 1); return ((kk >> 3) * 4 + (c >> 5)) * 512 + ((kk & 7) * 32 + (c & 31)) * 2; }
__device__ __forceinline__ int v_rd_base(int lane) { return ((lane & 3) << 3) | (((lane >> 2) & 3) << 6) | (((lane >> 4) & 1) << 5) | (((lane >> 5) & 1) << 8); }
constexpr int v_rd_off(int d0, int ks, int half) { return d0 * 512 + ks * 4096 + half * 2048; }
struct AttnP { const bf16* Kg; const bf16* Vg; int ldk; int ntiles; int tq; unsigned W; float sl2; float tref; };

__device__ __forceinline__ void qkt(f32x16& p0, f32x16& p1, const char* Kt, int r32, int hi, const bf16x8 (&qr)[8]) {
    const char* kb[4];
#pragma unroll
    for (int dd = 0; dd < 4; ++dd) kb[dd] = Kt + KSWZ(r32, (dd * 16 + hi * 8) * 2);
#pragma unroll
    for (int d0 = 0; d0 < 8; ++d0) { const char* a = kb[d0 & 3] + (d0 >> 2) * 128;
        const bf16x8 b0 = *reinterpret_cast<const bf16x8*>(a);
        const bf16x8 b1 = *reinterpret_cast<const bf16x8*>(a + 32 * 256);
        p0 = __builtin_amdgcn_mfma_f32_32x32x16_bf16(b0, qr[d0], p0, 0, 0, 0);
        p1 = __builtin_amdgcn_mfma_f32_32x32x16_bf16(b1, qr[d0], p1, 0, 0, 0); }
}
#define KRD_(dst, ad, off) asm volatile("ds_read_b128 %0, %1 offset:%2" : "=&v"(dst) : "v"(ad), "i"(off) : "memory")
#define KPAIR_(j) do { KRD_(b0[j], ka[(j) & 3], ((j) >> 2) * 128); KRD_(b1[j], ka[(j) & 3], ((j) >> 2) * 128 + 8192); } while (0)
#define KWAIT_(n) asm volatile("s_waitcnt lgkmcnt(%0)" :: "i"(n) : "memory")
template <int WIN>
__device__ __forceinline__ void qkt_pre(f32x16& p0, f32x16& p1, const char* Kt, int r32, int hi, const bf16x8 (&qr)[8]) {
    int ka[4];
#pragma unroll
    for (int dd = 0; dd < 4; ++dd) ka[dd] = (int)(unsigned)(uintptr_t)Kt + KSWZ(r32, (dd * 16 + hi * 8) * 2);
    bf16x8 b0[8], b1[8];
    KWAIT_(0); SBAR();
#define KSTEP_(j) do { if ((j) + WIN < 8) KPAIR_(((j) + WIN) & 7); \
        { constexpr int out_ = ((j) + WIN < 8 ? WIN : 7 - (j)) * 2; KWAIT_(out_); } SBAR(); \
        p0 = __builtin_amdgcn_mfma_f32_32x32x16_bf16(b0[j], qr[j], p0, 0, 0, 0); p1 = __builtin_amdgcn_mfma_f32_32x32x16_bf16(b1[j], qr[j], p1, 0, 0, 0); SBAR(); } while (0)
    KPAIR_(0); if (WIN > 1) KPAIR_(1); if (WIN > 2) KPAIR_(2); if (WIN > 3) KPAIR_(3); if (WIN > 4) KPAIR_(4); if (WIN > 5) KPAIR_(5); if (WIN > 6) KPAIR_(6); if (WIN > 7) KPAIR_(7);
    KSTEP_(0); KSTEP_(1); KSTEP_(2); KSTEP_(3); KSTEP_(4); KSTEP_(5); KSTEP_(6); KSTEP_(7);
#undef KSTEP_
}
__device__ __forceinline__ void pv_tile(f32x16 (&o)[4], int vb0, bf16x8 pa0, bf16x8 pa1, bf16x8 pa2, bf16x8 pa3) {
#define TRRD(dst, off) asm volatile("ds_read_b64_tr_b16 %0, %1 offset:%2" : "=&v"(dst) : "v"(vb0), "i"(off) : "memory")
#define PV_D0(d0) do { s16x4 l0, l1, l2, l3, h0, h1, h2, h3; constexpr int b_ = v_rd_off(d0, 0, 0); \
        TRRD(l0, b_); TRRD(h0, b_ + 2048); TRRD(l1, b_ + 4096); TRRD(h1, b_ + 6144); TRRD(l2, b_ + 8192); TRRD(h2, b_ + 10240); TRRD(l3, b_ + 12288); TRRD(h3, b_ + 14336); \
        asm volatile("s_waitcnt lgkmcnt(0)" ::: "memory"); SBAR(); \
        o[d0] = __builtin_amdgcn_mfma_f32_32x32x16_bf16(pa0, (bf16x8){l0[0], l0[1], l0[2], l0[3], h0[0], h0[1], h0[2], h0[3]}, o[d0], 0, 0, 0); \
        o[d0] = __builtin_amdgcn_mfma_f32_32x32x16_bf16(pa1, (bf16x8){l1[0], l1[1], l1[2], l1[3], h1[0], h1[1], h1[2], h1[3]}, o[d0], 0, 0, 0); \
        o[d0] = __builtin_amdgcn_mfma_f32_32x32x16_bf16(pa2, (bf16x8){l2[0], l2[1], l2[2], l2[3], h2[0], h2[1], h2[2], h2[3]}, o[d0], 0, 0, 0); \
        o[d0] = __builtin_amdgcn_mfma_f32_32x32x16_bf16(pa3, (bf16x8){l3[0], l3[1], l3[2], l3[3], h3[0], h3[1], h3[2], h3[3]}, o[d0], 0, 0, 0); } while (0)
    PV_D0(0); PV_D0(1); PV_D0(2); PV_D0(3);
#undef PV_D0
#undef TRRD
}
#define TRRD2(dst, off) asm volatile("ds_read_b64_tr_b16 %0, %1 offset:%2" : "=&v"(dst) : "v"(vb0), "i"(off) : "memory")
#define PVP_RD(S, g) do { constexpr int b_ = ((g) >> 2) * 16384 + ((g) & 3) * 512; TRRD2(S[0], b_); TRRD2(S[1], b_ + 2048); TRRD2(S[2], b_ + 4096); TRRD2(S[3], b_ + 6144); \
        TRRD2(S[4], b_ + 8192); TRRD2(S[5], b_ + 10240); TRRD2(S[6], b_ + 12288); TRRD2(S[7], b_ + 14336); } while (0)
#define PVP_MM(S, g) do { \
        o[g] = __builtin_amdgcn_mfma_f32_32x32x16_bf16(pa0, (bf16x8){S[0][0], S[0][1], S[0][2], S[0][3], S[1][0], S[1][1], S[1][2], S[1][3]}, o[g], 0, 0, 0); \
        o[g] = __builtin_amdgcn_mfma_f32_32x32x16_bf16(pa1, (bf16x8){S[2][0], S[2][1], S[2][2], S[2][3], S[3][0], S[3][1], S[3][2], S[3][3]}, o[g], 0, 0, 0); \
        o[g] = __builtin_amdgcn_mfma_f32_32x32x16_bf16(pa2, (bf16x8){S[4][0], S[4][1], S[4][2], S[4][3], S[5][0], S[5][1], S[5][2], S[5][3]}, o[g], 0, 0, 0); \
        o[g] = __builtin_amdgcn_mfma_f32_32x32x16_bf16(pa3, (bf16x8){S[6][0], S[6][1], S[6][2], S[6][3], S[7][0], S[7][1], S[7][2], S[7][3]}, o[g], 0, 0, 0); } while (0)
#define PVP_STEP(CUR, NXT, g, NG_) do { if ((g) + 1 < (NG_)) { PVP_RD(NXT, (g) + 1); asm volatile("s_waitcnt lgkmcnt(8)" ::: "memory"); } else { asm volatile("s_waitcnt lgkmcnt(0)" ::: "memory"); } SBAR(); PVP_MM(CUR, g); SBAR(); } while (0)
template <int NG>
__device__ __forceinline__ void pv_pipe(f32x16 (&o)[NG], int vb0, bf16x8 pa0, bf16x8 pa1, bf16x8 pa2, bf16x8 pa3) {
    s16x4 A[8], B[8];
    asm volatile("s_waitcnt lgkmcnt(0)" ::: "memory"); SBAR();
    PVP_RD(A, 0);
    PVP_STEP(A, B, 0, NG); PVP_STEP(B, A, 1, NG); PVP_STEP(A, B, 2, NG); PVP_STEP(B, A, 3, NG);
    if constexpr (NG == 8) { PVP_STEP(A, B, 4, NG); PVP_STEP(B, A, 5, NG); PVP_STEP(A, B, 6, NG); PVP_STEP(B, A, 7, NG); }
}
template <bool IMP, bool SEL, bool NOPV = false>
__device__ __forceinline__ void attn_run(char* shm, const AttnP a, const bf16x8 (&qr)[8], f32x16 (&o)[4], float& m_reg, float& l_reg, int vhalf,
                                         float inv_l, int impq) {
    int tid_ = threadIdx.x; asm volatile("" : "+v"(tid_));
    const int tid = tid_, wid = __builtin_amdgcn_readfirstlane(tid >> 6), lane = tid & 63, r32 = lane & 31, hi = lane >> 5;
    float* wsf = (float*)(shm + AT_WS) + wid * 64;
    int wbo_ = AT_WS + wid * 256 + 16 * hi; asm volatile("" : "+v"(wbo_)); const LAS float* wb = (const LAS float*)((LAS char*)shm + wbo_);
    const int* list = (const int*)(shm + AT_LIST);
    const int vb00 = (int)(unsigned)(uintptr_t)shm + AT_KSZ + v_rd_base(lane); (void)vhalf;
    unsigned koff[2], voff[2];
#pragma unroll
    for (int i2 = 0; i2 < 2; ++i2) { const int pk = wid * 2 + i2;
        const int row = 4 * pk + (lane >> 4), c = (lane & 15) ^ (row & 7); koff[i2] = (unsigned)(row * a.ldk + c * 8) * 2u;
        const int st = 2 * pk + (lane >> 5), pos = lane & 31, kk = (st >> 2) * 8 + (pos >> 2), k = (kk & ~0xC) | ((kk & 4) << 1) | ((kk & 8) >> 1), cv = (st & 3) * 32 + (pos & 3) * 8;
        voff[i2] = (unsigned)(k * a.ldk + cv) * 2u; }
    LAS unsigned char* lbase = (LAS unsigned char*)shm + wid * 2048;
#define DMA16(gp_, lp_) __builtin_amdgcn_global_load_lds((const unsigned*)(gp_), (LAS unsigned*)(lp_), 16, 0, 0)
#define STAGE(kb_, bo_) do { const char* kt_ = (const char*)(a.Kg + (size_t)(kb_) * a.ldk); const char* vt_ = (const char*)(a.Vg + (size_t)(kb_) * a.ldk); \
        DMA16(kt_ + koff[0], lbase + (bo_)); DMA16(kt_ + koff[1], lbase + (bo_) + 1024); \
        DMA16(vt_ + voff[0], lbase + (bo_) + AT_KSZ); DMA16(vt_ + voff[1], lbase + (bo_) + AT_KSZ + 1024); } while (0)
    int kb = __builtin_amdgcn_readfirstlane(list[0]);
    STAGE(kb, 0);
    int kbn = kb;
    if (a.ntiles > 1) { kbn = __builtin_amdgcn_readfirstlane(list[1]); STAGE(kbn, 32768); }
    VM_WAIT(); __syncthreads();
    int bo = 0;
    for (int i = 0; i < a.ntiles; ++i) {
        const bool more2 = i + 2 < a.ntiles;
        int kbn2 = kbn;
        if (more2) { kbn2 = __builtin_amdgcn_readfirstlane(list[i + 2]); const int b2 = bo >= 32768 ? bo - 32768 : bo + 65536; STAGE(kbn2, b2); }
        const int d0 = a.tq - kb;
        bool selok = true;
        if (SEL) { const int blk = kb >> 6; const unsigned w = ((const unsigned*)(shm + AT_SELM))[impq * 4 + (blk >> 5)]; selok = ((w >> (blk & 31)) & 1u) != 0u; }
        const bool anyv = selok && d0 >= 0 && (d0 - 63 < (int)a.W), full = selok && d0 >= 63 && (unsigned)d0 < a.W;
        if (__any(anyv)) {
        const bool unset = m_reg < -1e29f;
        const float ref = unset ? 0.f : m_reg;
        f32x16 p0, p1;
        { const float B0 = a.sl2 * ((float)(kb + 4 * hi) - a.tref) - ref;
#pragma unroll
          for (int r = 0; r < 16; ++r) { p0[r] = __builtin_fmaf(a.sl2, (float)((r & 3) + 8 * (r >> 2)), B0); p1[r] = __builtin_fmaf(a.sl2, (float)((r & 3) + 8 * (r >> 2) + 32), B0); } }
        qkt(p0, p1, shm + bo, r32, hi, qr);
        if (!__all(full)) {
            const int dq = selok ? d0 - 4 * hi : -1; const float NEG = -__builtin_inff();
#pragma unroll
            for (int r = 0; r < 16; ++r) { const int c = (r & 3) + 8 * (r >> 2);
                if ((unsigned)(dq - c) >= a.W) p0[r] = NEG;
                if ((unsigned)(dq - c - 32) >= a.W) p1[r] = NEG; } }
        float pmax = p0[0];
#pragma unroll
        for (int r = 1; r < 16; ++r) pmax = fmaxf(pmax, p0[r]);
#pragma unroll
        for (int r = 0; r < 16; ++r) pmax = fmaxf(pmax, p1[r]);
        { auto rr = __builtin_amdgcn_permlane32_swap(__float_as_uint(pmax), __float_as_uint(pmax), false, false); pmax = fmaxf(__uint_as_float(rr[0]), __uint_as_float(rr[1])); }
        const bool need = unset ? (pmax > -1e30f) : (pmax > 8.0f);
        if (__any(need)) {
            const float delta = need ? pmax : 0.f, alpha = (need && !unset) ? __builtin_amdgcn_exp2f(-pmax) : 1.0f;
            m_reg = need ? ref + pmax : m_reg;
#pragma unroll
            for (int r = 0; r < 16; ++r) { p0[r] -= delta; p1[r] -= delta; }
            l_reg *= alpha;
            if (__any(alpha < 1.f)) { if (hi == 0) wsf[r32] = alpha; LDS_WAIT();
#pragma unroll
                for (int r = 0; r < 16; ++r) { const float f = wb[(r & 3) + 8 * (r >> 2)];
#pragma unroll
                    for (int d = 0; d < 4; ++d) o[d][r] *= f; }
                LDS_WAIT(); }
        }
#pragma unroll
        for (int r = 0; r < 16; ++r) { p0[r] = __builtin_amdgcn_exp2f(p0[r]); p1[r] = __builtin_amdgcn_exp2f(p1[r]); }
        float ps = 0.f;
#pragma unroll
        for (int r = 0; r < 16; ++r) ps += p0[r] + p1[r];
        { auto rr = __builtin_amdgcn_permlane32_swap(__float_as_uint(ps), __float_as_uint(ps), false, false); ps = __uint_as_float(rr[0]) + __uint_as_float(rr[1]); }
        l_reg += ps;
        if (IMP) {
            float* imp = (float*)(shm + AT_IMP) + impq * 129 + (kb >> 2) + hi;
#pragma unroll
            for (int j = 0; j < 4; ++j) {
                const float a0 = ((p0[4 * j] + p0[4 * j + 1]) + (p0[4 * j + 2] + p0[4 * j + 3])) * inv_l, b0 = p0[4 * j + 3] * inv_l;
                const float a1 = ((p1[4 * j] + p1[4 * j + 1]) + (p1[4 * j + 2] + p1[4 * j + 3])) * inv_l, b1 = p1[4 * j + 3] * inv_l;
                const int n0 = (kb >> 2) + hi + 2 * j;
                unsigned* impu = (unsigned*)imp;
                atomicAdd(impu + 2 * j, (unsigned)(a0 * 16777216.f + 0.5f)); atomicAdd(impu + 2 * j + 1, (unsigned)(b0 * 16777216.f + 0.5f));
                atomicAdd(impu + 2 * j + 8, (unsigned)(a1 * 16777216.f + 0.5f)); if (n0 + 9 < 128) atomicAdd(impu + 2 * j + 9, (unsigned)(b1 * 16777216.f + 0.5f));
            }
        }
        bf16x8 pa0, pa1, pa2, pa3;
#define PK4(P, B_, OUT) do { unsigned a0_ = cvtpk(P[B_+0], P[B_+1]), a1_ = cvtpk(P[B_+2], P[B_+3]); unsigned b0_ = cvtpk(P[B_+4], P[B_+5]), b1_ = cvtpk(P[B_+6], P[B_+7]); \
        auto r0_ = __builtin_amdgcn_permlane32_swap(a0_, b0_, false, false); auto r1_ = __builtin_amdgcn_permlane32_swap(a1_, b1_, false, false); \
        v4u w_ = {r0_[0], r1_[0], r0_[1], r1_[1]}; OUT = __builtin_bit_cast(bf16x8, w_); } while (0)
        PK4(p0, 0, pa0); PK4(p0, 8, pa1); PK4(p1, 0, pa2); PK4(p1, 8, pa3);
#undef PK4
        SBAR();
        if (!NOPV) pv_pipe<4>(o, vb00 + bo, pa0, pa1, pa2, pa3);
        }
        if (more2) asm volatile("s_waitcnt vmcnt(4) lgkmcnt(0)" ::: "memory"); else asm volatile("s_waitcnt vmcnt(0) lgkmcnt(0)" ::: "memory");
        __builtin_amdgcn_s_barrier(); asm volatile("" ::: "memory");
        kb = kbn; kbn = kbn2; bo = bo >= 65536 ? 0 : bo + 32768;
    }
#undef STAGE
#undef DMA16
}
__device__ __forceinline__ const LAS float* lds_at(char* shm, int off) { asm volatile("" : "+v"(off)); return (const LAS float*)((LAS char*)shm + off); }
typedef GAS unsigned long long gu64;
constexpr int DJ_K = 0, DJ_V = 49152, DJ_P = 114688, DJ_AL = 147456;
static_assert(DJ_AL + 2048 <= LDSCTL_OFF, "diff job LDS map");
__device__ __forceinline__ void diff_job(const bf16* proj, bf16* mix, float* dpart, unsigned* dcnt, const float* __restrict__ dnorm, float lam, int h, int qt, int map, int jlo, char* shm,
                                         volatile LAS unsigned* qw, const int hot = 0) {
    int tid_ = threadIdx.x; asm volatile("" : "+v"(tid_));
    const int tid = tid_, wid = __builtin_amdgcn_readfirstlane(tid >> 6), lane = tid & 63, r32 = lane & 31, hi = lane >> 5;
    const bool prod = wid < 4;
    const int rg = wid & 3, t0 = 128 * qt, t = t0 + 32 * rg + r32, ntiles = 2 * (qt + 1) - jlo;
    const float sl2 = __builtin_amdgcn_exp2f(-(float)(h + 1)) * LOG2E, tref = (float)t0;
    const bf16* Kg = PVEC(proj, OFF_DK + h * 256 + map * 128); const bf16* Vg = PVEC(proj, OFF_DV + h * 256);
    unsigned koff[2], voff[2];
#pragma unroll
    for (int i2 = 0; i2 < 2; ++i2) { const int pk = wid * 2 + i2;
        const int row = 4 * pk + (lane >> 4), c = (lane & 15) ^ (row & 7); koff[i2] = (unsigned)(row * 128 + c * 8) * 2u;
        const int st = 2 * pk + (lane >> 5), pos = lane & 31, kk = (st >> 2) * 8 + (pos >> 2), k = (kk & ~0xC) | ((kk & 4) << 1) | ((kk & 8) >> 1), cv = (st & 3) * 32 + (pos & 3) * 8;
        voff[i2] = (unsigned)(k * 128 + cv) * 2u; }
    LAS unsigned char* lbase = (LAS unsigned char*)shm + wid * 2048;
#define DMA16(gp_, lp_) __builtin_amdgcn_global_load_lds((const unsigned*)(gp_), (LAS unsigned*)(lp_), 16, 0, 0)
#define STAGE_K(kb_, so_) do { const char* kt_ = (const char*)(Kg + (size_t)(kb_) * 128); DMA16(kt_ + koff[0], lbase + DJ_K + (so_)); DMA16(kt_ + koff[1], lbase + DJ_K + (so_) + 1024); } while (0)
#define STAGE_V(kb_, so_) do { const char* vt_ = (const char*)(Vg + (size_t)(kb_) * 128); const char* vt2_ = vt_ + (size_t)SEQ * 256; DMA16(vt_ + voff[0], lbase + DJ_V + (so_)); DMA16(vt_ + voff[1], lbase + DJ_V + (so_) + 1024); \
        DMA16(vt2_ + voff[0], lbase + DJ_V + (so_) + 16384); DMA16(vt2_ + voff[1], lbase + DJ_V + (so_) + 16384 + 1024); } while (0)
    float* alb = (float*)(shm + DJ_AL);
    int wbo_ = DJ_AL + rg * 128 + 16 * hi; asm volatile("" : "+v"(wbo_)); const LAS float* wb = (const LAS float*)((LAS char*)shm + wbo_);
    const int vb00 = (int)(unsigned)(uintptr_t)shm + DJ_V + v_rd_base(lane);
    f32x16 o[8];
    STAGE_K(64 * jlo, 0); if (ntiles > 1) STAGE_K(64 * jlo + 64, AT_KSZ); VM_WAIT(); __syncthreads();
    if (prod) {
        bf16x8 qr[8];
        { const bf16* qrow = PVEC(proj, OFF_DQ + h * 256 + map * 128) + (size_t)t * 128 + hi * 8;
#pragma unroll
          for (int d0 = 0; d0 < 8; ++d0) qr[d0] = *(const bf16x8*)(qrow + d0 * 16); }
        float m_reg = -1e30f, l_reg = 0.f;
        f32x16 pA0, pA1, pB0, pB1; float rfA = 0.f, rfB = 0.f;
#define DJ_QK(P0, P1, RF, ii) do { const int kb_ = 64 * (jlo + (ii)); RF = (m_reg < -1e29f) ? 0.f : m_reg; const float B0_ = sl2 * ((float)(kb_ + 4 * hi) - tref) - RF; \
            _Pragma("unroll") for (int r = 0; r < 16; ++r) { P0[r] = __builtin_fmaf(sl2, (float)((r & 3) + 8 * (r >> 2)), B0_); P1[r] = __builtin_fmaf(sl2, (float)((r & 3) + 8 * (r >> 2) + 32), B0_); } \
            if (hot != 5) qkt_pre<8>(P0, P1, shm + DJ_K + ((ii) % 3) * AT_KSZ, r32, hi, qr); } while (0)
#define DJ_SM(P0, P1, RF, ii) do { if (hot == 6) { asm volatile("" : "+v"(P0), "+v"(P1)); break; } const int kb_ = 64 * (jlo + (ii)); const int d0_ = t - kb_; \
            if (!__all(d0_ >= 63)) { const int dq_ = d0_ - 4 * hi; const float NEG_ = -__builtin_inff(); \
                _Pragma("unroll") for (int r = 0; r < 16; ++r) { const int c_ = (r & 3) + 8 * (r >> 2); if (dq_ - c_ < 0) P0[r] = NEG_; if (dq_ - c_ - 32 < 0) P1[r] = NEG_; } } \
            const bool unset_ = m_reg < -1e29f; const float ref_ = unset_ ? 0.f : m_reg; const float adj_ = ref_ - RF;     \
            float pmax_ = P0[0]; \
            _Pragma("unroll") for (int r = 1; r < 16; ++r) pmax_ = fmaxf(pmax_, P0[r]); \
            _Pragma("unroll") for (int r = 0; r < 16; ++r) pmax_ = fmaxf(pmax_, P1[r]); \
            { auto rr_ = __builtin_amdgcn_permlane32_swap(__float_as_uint(pmax_), __float_as_uint(pmax_), false, false); pmax_ = fmaxf(__uint_as_float(rr_[0]), __uint_as_float(rr_[1])); } \
            pmax_ -= adj_; \
            const bool need_ = unset_ ? (pmax_ > -1e30f) : (pmax_ > 8.0f); \
            float alpha_ = 1.0f; float sub_ = adj_; \
            if (__any(need_)) { alpha_ = (need_ && !unset_) ? __builtin_amdgcn_exp2f(-pmax_) : 1.0f; m_reg = need_ ? ref_ + pmax_ : m_reg; sub_ += need_ ? pmax_ : 0.f; l_reg *= alpha_; } \
            if (__any(sub_ != 0.f)) { _Pragma("unroll") for (int r = 0; r < 16; ++r) { P0[r] -= sub_; P1[r] -= sub_; } } \
            _Pragma("unroll") for (int r = 0; r < 16; ++r) { P0[r] = __builtin_amdgcn_exp2f(P0[r]); P1[r] = __builtin_amdgcn_exp2f(P1[r]); } \
            float ps_ = 0.f; \
            _Pragma("unroll") for (int r = 0; r < 16; ++r) ps_ += P0[r] + P1[r]; \
            { auto rr_ = __builtin_amdgcn_permlane32_swap(__float_as_uint(ps_), __float_as_uint(ps_), false, false); ps_ = __uint_as_float(rr_[0]) + __uint_as_float(rr_[1]); } \
            l_reg += ps_; \
            bf16x8 pa0_, pa1_, pa2_, pa3_; \
            DJ_PK4(P0, 0, pa0_); DJ_PK4(P0, 8, pa1_); DJ_PK4(P1, 0, pa2_); DJ_PK4(P1, 8, pa3_); \
            bf16x8* pb_ = (bf16x8*)(shm + DJ_P + ((ii) & 1) * 16384 + rg * 4096) + lane; \
            pb_[0] = pa0_; pb_[64] = pa1_; pb_[128] = pa2_; pb_[192] = pa3_; \
            if (hi == 0) alb[((ii) & 1) * 128 + rg * 32 + r32] = alpha_; } while (0)
#define DJ_PK4(P, B_, OUT) do { unsigned a0_ = cvtpk(P[B_+0], P[B_+1]), a1_ = cvtpk(P[B_+2], P[B_+3]); unsigned b0_ = cvtpk(P[B_+4], P[B_+5]), b1_ = cvtpk(P[B_+6], P[B_+7]); \
            auto r0_ = __builtin_amdgcn_permlane32_swap(a0_, b0_, false, false); auto r1_ = __builtin_amdgcn_permlane32_swap(a1_, b1_, false, false); \
            v4u w_ = {r0_[0], r1_[0], r0_[1], r1_[1]}; OUT = __builtin_bit_cast(bf16x8, w_); } while (0)
#define DJ_STAGE(ii) do { if (hot < 2) { if ((ii) + 2 < ntiles) STAGE_K(64 * (jlo + (ii) + 2), (((ii) + 2) % 3) * AT_KSZ); if ((ii) < ntiles) STAGE_V(64 * (jlo + (ii)), ((ii) & 1) * 32768); } } while (0)
        DJ_QK(pA0, pA1, rfA, 0);
        int i = 0;
        for (; i + 1 < ntiles; i += 2) {
            DJ_STAGE(i);     DJ_QK(pB0, pB1, rfB, i + 1);                         DJ_SM(pA0, pA1, rfA, i);     VM_WAIT(); __syncthreads();
            DJ_STAGE(i + 1); if (i + 2 < ntiles) DJ_QK(pA0, pA1, rfA, i + 2);     DJ_SM(pB0, pB1, rfB, i + 1); VM_WAIT(); __syncthreads();
        }
        if (i < ntiles) { DJ_STAGE(i); DJ_SM(pA0, pA1, rfA, i); VM_WAIT(); __syncthreads(); ++i; }
        DJ_STAGE(i); VM_WAIT(); __syncthreads();
#undef DJ_QK
#undef DJ_SM
#undef DJ_PK4
        if (hi == 0) alb[256 + rg * 32 + r32] = l_reg;
    } else {
#pragma unroll
        for (int d = 0; d < 8; ++d) o[d] = f32x16{};
        for (int i = 0; i <= ntiles; ++i) {
            const int kb = 64 * (jlo + i);
            DJ_STAGE(i);
            if (i >= 1 && hot != 3) {
                const int sl = (i - 1) & 1;
                { bool any = false; float f[16];
#pragma unroll
                  for (int r = 0; r < 16; ++r) { f[r] = wb[sl * 128 + (r & 3) + 8 * (r >> 2)]; any |= f[r] < 1.f; }
                  if (__any(any)) {
#pragma unroll
                      for (int r = 0; r < 16; ++r)
#pragma unroll
                          for (int d = 0; d < 8; ++d) o[d][r] *= f[r]; } }
                const bf16x8* pb = (const bf16x8*)(shm + DJ_P + sl * 16384 + rg * 4096) + lane;
                bf16x8 pa0 = pb[0], pa1 = pb[64], pa2 = pb[128], pa3 = pb[192];
                asm volatile("" : "+v"(pa0), "+v"(pa1), "+v"(pa2), "+v"(pa3));
                pv_pipe<8>(o, vb00 + sl * 32768, pa0, pa1, pa2, pa3);
            }
            VM_WAIT();
            __syncthreads();
        }
    }
#undef DJ_STAGE
#undef STAGE_K
#undef STAGE_V
#undef DMA16
    __syncthreads();
    const int pair = h * 64 + qt, ctid = tid - 256;
    if (hot) { __syncthreads(); return; }
    if (!prod) {
#pragma unroll
        for (int r = 0; r < 16; ++r) { const float rl = __builtin_amdgcn_rcpf(wb[256 + (r & 3) + 8 * (r >> 2)]);
#pragma unroll
            for (int d = 0; d < 8; ++d) o[d][r] *= rl; }
        const char* mine = (const char*)(dpart + (size_t)(pair * 2 + map) * 32768);
#pragma unroll
        for (int d = 0; d < 8; ++d)
#pragma unroll
            for (int r4 = 0; r4 < 4; ++r4) { gu64* p = (gu64*)(mine + (d * 4 + r4) * 2048) + ctid;
                const unsigned lo = cvtpk(o[d][4 * r4], o[d][4 * r4 + 1]), hi2 = cvtpk(o[d][4 * r4 + 2], o[d][4 * r4 + 3]);
                __hip_atomic_store(p, ((unsigned long long)hi2 << 32) | lo, RLX_AGENT);
                o[d][4 * r4] = __uint_as_float(lo << 16); o[d][4 * r4 + 1] = __uint_as_float(lo & 0xffff0000u); o[d][4 * r4 + 2] = __uint_as_float(hi2 << 16); o[d][4 * r4 + 3] = __uint_as_float(hi2 & 0xffff0000u); }
    }
    asm volatile("s_waitcnt vmcnt(0)" ::: "memory");
    __syncthreads();
    if (tid == 0) qw[1] = __hip_atomic_fetch_add(dcnt + 64 * pair, 1u, __ATOMIC_RELAXED, __HIP_MEMORY_SCOPE_AGENT);
    __syncthreads();
    const unsigned old = (unsigned)__builtin_amdgcn_readfirstlane((int)qw[1]);
    __syncthreads();
    if (old == 0u) return;
    if (!prod) {
        const char* theirs = (const char*)(dpart + (size_t)(pair * 2 + (map ^ 1)) * 32768);
#pragma unroll
        for (int d = 0; d < 8; ++d) {
#pragma unroll
            for (int r4 = 0; r4 < 4; ++r4) { gu64* p = (gu64*)(theirs + (d * 4 + r4) * 2048) + ctid;
                const unsigned long long w = __hip_atomic_load(p, RLX_AGENT); const unsigned lo = (unsigned)w, hi2 = (unsigned)(w >> 32);
                const float p0 = __uint_as_float(lo << 16), p1 = __uint_as_float(lo & 0xffff0000u), p2 = __uint_as_float(hi2 << 16), p3 = __uint_as_float(hi2 & 0xffff0000u);
                const float a0 = o[d][4 * r4], a1 = o[d][4 * r4 + 1], a2 = o[d][4 * r4 + 2], a3 = o[d][4 * r4 + 3];
                o[d][4 * r4] = map ? (p0 - lam * a0) : (a0 - lam * p0); o[d][4 * r4 + 1] = map ? (p1 - lam * a1) : (a1 - lam * p1);
                o[d][4 * r4 + 2] = map ? (p2 - lam * a2) : (a2 - lam * p2); o[d][4 * r4 + 3] = map ? (p3 - lam * a3) : (a3 - lam * p3); }
            asm volatile("" : "+v"(o[d]) :: "memory"); }
        float gn[8];
#pragma unroll
        for (int d = 0; d < 8; ++d) gn[d] = dnorm[32 * d + r32] * (1.0f - LAM0);
#pragma unroll
        for (int r = 0; r < 16; ++r) { float s = 0.f;
#pragma unroll
            for (int d = 0; d < 8; ++d) s += o[d][r] * o[d][r];
            s += swz_xor<1>(s); s += swz_xor<2>(s); s += swz_xor<4>(s); s += swz_xor<8>(s); s += swz_xor<16>(s);
            const float sc = 1.0f / sqrtf(s * (1.0f / 256.0f) + EPS);
            bf16* orow = mix + (size_t)(t0 + 32 * rg + crow(r, hi)) * DM + h * 256 + r32;
#pragma unroll
            for (int d = 0; d < 8; ++d) { const float v = o[d][r] * sc * gn[d]; const float vn = dpp_xor1(v);
                if ((r32 & 1) == 0) *(unsigned*)(orow + 32 * d) = cvtpk(v, vn); } }
    }
    __syncthreads();
}
__device__ __forceinline__ void norm_pass(const bf16* proj, float* slots, int bx, int G, char* shm) {
    const int tid = threadIdx.x, wave = tid >> 6, ln = tid & 63, v = ln >> 1, half = ln & 1;
    float mx = 0.f;
    for (int t = bx * NWAVES + wave; t < SEQ; t += G * NWAVES) {
        const v4u* p = (const v4u*)(PVEC(proj, v * 128) + (size_t)t * 128 + half * 64);
        float s = 0.f;
#pragma unroll
        for (int i = 0; i < 8; ++i) { const v4u w = p[i];
            const float a0 = __uint_as_float(w.x << 16), a1 = __uint_as_float(w.x & 0xffff0000u), a2 = __uint_as_float(w.y << 16), a3 = __uint_as_float(w.y & 0xffff0000u);
            const float a4 = __uint_as_float(w.z << 16), a5 = __uint_as_float(w.z & 0xffff0000u), a6 = __uint_as_float(w.w << 16), a7 = __uint_as_float(w.w & 0xffff0000u);
            s += (a0 * a0 + a1 * a1) + (a2 * a2 + a3 * a3) + (a4 * a4 + a5 * a5) + (a6 * a6 + a7 * a7); }
        s += dpp_xor1(s);
        mx = fmaxf(mx, s);
    }
    float* red = (float*)shm;
    if (half == 0) red[wave * 32 + v] = mx;
    __syncthreads();
    if (tid < 32) { float m = red[tid];
#pragma unroll
        for (int w = 1; w < NWAVES; ++w) m = fmaxf(m, red[w * 32 + tid]);
        slots[bx * 32 + tid] = sqrtf(m) * 1.004f; }
    __syncthreads();
}
__device__ __forceinline__ void nsa_unit(const bf16* proj, const bf16* kc, const bf16* vc, bf16* mix, float* scr, const float* __restrict__ gate_bias, int hkv, int qt, char* shm, const int probe = 0) {
    int tid_ = threadIdx.x; asm volatile("" : "+v"(tid_));
    const int tid = tid_, wid = __builtin_amdgcn_readfirstlane(tid >> 6), lane = tid & 63, r32 = lane & 31, hi = lane >> 5;
    const int g = wid & 3, qs = wid >> 2, t0 = 64 * qt, q = 32 * qs + r32, t = t0 + q, head = hkv * 4 + g;
    int* list = (int*)(shm + AT_LIST);
    float* wsf = (float*)(shm + AT_WS) + wid * 64;
    float* gates = (float*)(shm + AT_GATE);
    float* imp = (float*)(shm + AT_IMP);
    unsigned* uni = (unsigned*)(shm + AT_UNI);
    unsigned short* selm16 = (unsigned short*)(shm + AT_SELM);
    const float slope = __builtin_amdgcn_exp2f(-0.5f * (float)(head + 1));
    for (int i = tid; i < 64 * 129; i += 512) imp[i] = 0.f;
    if (tid < 8) uni[tid] = 0u;
    for (int i = tid; i < 768; i += 512) { const int qq = i / 12, rem = i - qq * 12;
        const float v = bf2f(PVEC(proj, OFF_G)[(size_t)(t0 + qq) * 128 + hkv * 12 + rem]) + gate_bias[hkv * 12 + rem];
        gates[i] = __builtin_amdgcn_rcpf(1.0f + __builtin_amdgcn_exp2f(-LOG2E * v)); }
    const int ntc = ((t0 + 32) >> 10) + 1;
    if (tid < ntc) list[tid] = 64 * tid;
    __syncthreads();
    bf16x8 qr[8];
    { const bf16* qrow = PVEC(proj, OFF_NQ + head * 128) + (size_t)t * 128 + hi * 8;
#pragma unroll
      for (int d0 = 0; d0 < 8; ++d0) qr[d0] = *(const bf16x8*)(qrow + d0 * 16); }
    f32x16 o[4];
    float rf[16];
    const LAS float* wb = lds_at(shm, AT_WS + wid * 256 + 16 * hi);
    const LAS float* gb = lds_at(shm, AT_GATE + ((32 * qs + 4 * hi) * 12 + g * 3) * 4);
    {
        AttnP a; a.Kg = kc + (size_t)hkv * 512 * HD; a.Vg = vc + (size_t)hkv * 512 * HD; a.ldk = HD; a.ntiles = ntc; a.tq = (t >= 31) ? ((t - 31) >> 4) : -1; a.W = 0x7fffffffu;
        a.sl2 = 16.0f * slope * LOG2E; a.tref = ((float)t0 - 31.0f) * (1.0f / 16.0f);
#pragma unroll
        for (int d = 0; d < 4; ++d) o[d] = f32x16{};
        float m_reg = -1e30f, l_reg = 0.f;
        if (!(probe & 1)) attn_run<false, false, true>(shm, a, qr, o, m_reg, l_reg, 0, 0.f, 0);
        const float inv_l = l_reg > 0.f ? 1.0f / l_reg : 0.f;
#pragma unroll
        for (int d = 0; d < 4; ++d) o[d] = f32x16{};
        float l2 = 0.f;
        if (!(probe & 2)) { if (probe & 32) attn_run<false, false>(shm, a, qr, o, m_reg, l2, 0, inv_l, q); else attn_run<true, false>(shm, a, qr, o, m_reg, l2, 0, inv_l, q); }
        if (hi == 0) wsf[r32] = inv_l; LDS_WAIT();
#pragma unroll
        for (int r = 0; r < 16; ++r) rf[r] = wb[(r & 3) + 8 * (r >> 2)] * gb[12 * ((r & 3) + 8 * (r >> 2)) + 0];
        LDS_WAIT();
#pragma unroll
        for (int d = 0; d < 4; ++d)
#pragma unroll
            for (int c2 = 0; c2 < 2; ++c2) { v4u w;
                w.x = cvtpk(o[d][8 * c2 + 0] * rf[8 * c2 + 0], o[d][8 * c2 + 1] * rf[8 * c2 + 1]); w.y = cvtpk(o[d][8 * c2 + 2] * rf[8 * c2 + 2], o[d][8 * c2 + 3] * rf[8 * c2 + 3]);
                w.z = cvtpk(o[d][8 * c2 + 4] * rf[8 * c2 + 4], o[d][8 * c2 + 5] * rf[8 * c2 + 5]); w.w = cvtpk(o[d][8 * c2 + 6] * rf[8 * c2 + 6], o[d][8 * c2 + 7] * rf[8 * c2 + 7]);
                ((GAS v4u*)scr)[(d * 2 + c2) * 512 + tid] = w; }
    }
    {
        const int qq = tid >> 3, part = tid & 7;
        float s[16];
#pragma unroll
        for (int e = 0; e < 16; ++e) { const int n = part * 16 + e; const float v = (float)((const unsigned*)imp)[qq * 129 + n] * (1.0f / 16777216.f);
            s[e] = (n == 0 || n == qt || n == qt - 1) ? 1e4f : (n <= qt ? v : -1.0f); }
        __syncthreads();
#pragma unroll
        for (int e = 0; e < 16; ++e) imp[qq * 129 + part * 16 + e] = s[e];
        __syncthreads();
        unsigned bits = 0u;
        if (qt < 16) { if (part == 0) bits = (2u << qt) - 1u; }
        else {
            unsigned key[16];
#pragma unroll
            for (int e = 0; e < 16; ++e) key[e] = s[e] < 0.f ? 0u : __float_as_uint(s[e]) + 1u;
            unsigned T = 0u;
#pragma unroll 1
            for (int bit = 31; bit >= 0; --bit) { const unsigned c = T | (1u << bit); int cnt = 0;
#pragma unroll
                for (int e = 0; e < 16; ++e) cnt += key[e] >= c ? 1 : 0;
                cnt += __builtin_amdgcn_mov_dpp(cnt, 0xB1, 0xF, 0xF, true); cnt += __builtin_amdgcn_mov_dpp(cnt, 0x4E, 0xF, 0xF, true);
                cnt += __builtin_amdgcn_ds_swizzle(cnt, (4 << 10) | 0x1f);
                if (cnt >= 16) T = c; }
            int cgt = 0, ceq = 0;
#pragma unroll
            for (int e = 0; e < 16; ++e) { cgt += key[e] > T ? 1 : 0; ceq += key[e] == T ? 1 : 0; }
            cgt += __builtin_amdgcn_mov_dpp(cgt, 0xB1, 0xF, 0xF, true); cgt += __builtin_amdgcn_mov_dpp(cgt, 0x4E, 0xF, 0xF, true); cgt += __builtin_amdgcn_ds_swizzle(cgt, (4 << 10) | 0x1f);
            int pre = ceq;
            { const int l8 = tid & 7; int t1 = __shfl_up(pre, 1, 8); if (l8 >= 1) pre += t1; int t2 = __shfl_up(pre, 2, 8); if (l8 >= 2) pre += t2; int t4 = __shfl_up(pre, 4, 8); if (l8 >= 4) pre += t4; }
            int run = pre - ceq; const int need = 16 - cgt;
#pragma unroll
            for (int e = 0; e < 16; ++e) { const bool eq = key[e] == T; if (key[e] > T || (eq && run < need)) bits |= 1u << e; run += eq ? 1 : 0; }
        }
        selm16[qq * 8 + part] = (unsigned short)bits;
        if (bits) atomicOr(&uni[part >> 1], bits << (16 * (part & 1)));
        __syncthreads();
        if (tid < 128) {
            const unsigned u0 = uni[0], u1 = uni[1], u2 = uni[2], u3 = uni[3]; const int w = tid >> 5, b = tid & 31;
            const unsigned uw = w == 0 ? u0 : (w == 1 ? u1 : (w == 2 ? u2 : u3));
            if ((uw >> b) & 1u) { int pos = __popc(uw & ((1u << b) - 1u)); if (w > 0) pos += __popc(u0); if (w > 1) pos += __popc(u1); if (w > 2) pos += __popc(u2); list[pos] = 64 * tid; }
            if (tid == 0) uni[4] = (unsigned)(__popc(u0) + __popc(u1) + __popc(u2) + __popc(u3)); }
        __syncthreads();
    }
    {
        AttnP a; a.Kg = PVEC(proj, OFF_KS + hkv * HD); a.Vg = PVEC(proj, OFF_VS + hkv * HD); a.ldk = 128; a.ntiles = (int)uni[4]; a.tq = t; a.W = 0x7fffffffu; a.sl2 = slope * LOG2E; a.tref = (float)t0;
#pragma unroll
        for (int d = 0; d < 4; ++d) o[d] = f32x16{};
        float m_reg = -1e30f, l_reg = 0.f;
        if (!(probe & 4)) attn_run<false, true>(shm, a, qr, o, m_reg, l_reg, 0, 0.f, q);
        if (hi == 0) wsf[r32] = l_reg; LDS_WAIT();
#pragma unroll
        for (int r = 0; r < 16; ++r) rf[r] = __builtin_amdgcn_rcpf(wb[(r & 3) + 8 * (r >> 2)]) * gb[12 * ((r & 3) + 8 * (r >> 2)) + 1];
        LDS_WAIT();
#define BFLO(u_) __uint_as_float((u_) << 16)
#define BFHI(u_) __uint_as_float((u_) & 0xffff0000u)
#pragma unroll
        for (int d = 0; d < 4; ++d)
#pragma unroll
            for (int c2 = 0; c2 < 2; ++c2) { GAS v4u* p = (GAS v4u*)scr + (d * 2 + c2) * 512 + tid; const v4u t4 = *p; v4u w;
                w.x = cvtpk(BFLO(t4.x) + o[d][8 * c2 + 0] * rf[8 * c2 + 0], BFHI(t4.x) + o[d][8 * c2 + 1] * rf[8 * c2 + 1]); w.y = cvtpk(BFLO(t4.y) + o[d][8 * c2 + 2] * rf[8 * c2 + 2], BFHI(t4.y) + o[d][8 * c2 + 3] * rf[8 * c2 + 3]);
                w.z = cvtpk(BFLO(t4.z) + o[d][8 * c2 + 4] * rf[8 * c2 + 4], BFHI(t4.z) + o[d][8 * c2 + 5] * rf[8 * c2 + 5]); w.w = cvtpk(BFLO(t4.w) + o[d][8 * c2 + 6] * rf[8 * c2 + 6], BFHI(t4.w) + o[d][8 * c2 + 7] * rf[8 * c2 + 7]);
                *p = w; }
    }
    {
        const int jlo = qt >= 8 ? qt - 8 : 0, nw = qt - jlo + 1;
        if (tid < nw) list[tid] = 64 * (jlo + tid);
        __syncthreads();
        AttnP a; a.Kg = PVEC(proj, OFF_KW + hkv * HD); a.Vg = PVEC(proj, OFF_VW + hkv * HD); a.ldk = 128; a.ntiles = nw; a.tq = t; a.W = 512u; a.sl2 = slope * LOG2E; a.tref = (float)t0;
#pragma unroll
        for (int d = 0; d < 4; ++d) o[d] = f32x16{};
        float m_reg = -1e30f, l_reg = 0.f;
        if (!(probe & 8)) attn_run<false, false>(shm, a, qr, o, m_reg, l_reg, 0, 0.f, 0);
        if (probe) { __syncthreads(); return; }
        if (hi == 0) wsf[r32] = l_reg; LDS_WAIT();
#pragma unroll
        for (int r = 0; r < 16; ++r) rf[r] = __builtin_amdgcn_rcpf(wb[(r & 3) + 8 * (r >> 2)]) * gb[12 * ((r & 3) + 8 * (r >> 2)) + 2];
        LDS_WAIT();
        float tp[4][16];
#pragma unroll
        for (int d = 0; d < 4; ++d)
#pragma unroll
            for (int c2 = 0; c2 < 2; ++c2) { const v4u t4 = ((const GAS v4u*)scr)[(d * 2 + c2) * 512 + tid];
                tp[d][8 * c2 + 0] = BFLO(t4.x); tp[d][8 * c2 + 1] = BFHI(t4.x); tp[d][8 * c2 + 2] = BFLO(t4.y); tp[d][8 * c2 + 3] = BFHI(t4.y);
                tp[d][8 * c2 + 4] = BFLO(t4.z); tp[d][8 * c2 + 5] = BFHI(t4.z); tp[d][8 * c2 + 6] = BFLO(t4.w); tp[d][8 * c2 + 7] = BFHI(t4.w); }
#undef BFLO
#undef BFHI
#pragma unroll
        for (int r = 0; r < 16; ++r) { bf16* orow = mix + (size_t)(t0 + 32 * qs + crow(r, hi)) * DM + 2048 + head * 128 + r32;
#pragma unroll
            for (int d = 0; d < 4; ++d) { const float v = tp[d][r] + o[d][r] * rf[r]; const float vn = dpp_xor1(v);
                if ((r32 & 1) == 0) *(unsigned*)(orow + 32 * d) = cvtpk(v, vn); } }
    }
    __syncthreads();
}
#ifndef STOP_AFTER
#define STOP_AFTER -1
#endif
#ifndef DUMP_OFF
#define DUMP_OFF 0
#endif
#ifndef REP_P0
#define REP_P0 1
#endif
#ifndef REP_P1
#define REP_P1 1
#endif
#ifndef REP_P5
#define REP_P5 1
#endif
#ifndef REP_DIFF
#define REP_DIFF 1
#endif
#ifndef REP_NSA
#define REP_NSA 1
#endif
#ifndef REP_ONLY
#define REP_ONLY 0
#endif
constexpr int ITEMS_FF = (DM / 64) * (DFF / 64), ITEMS_IN = (DM / 64) * ((NIN + 63) / 64), TAIL_UP2 = ITEMS_FF, TAIL_DN2 = ITEMS_FF, TAIL_GT2 = 5888, TAIL_DN9 = ITEMS_FF, TAIL_DN1 = ITEMS_FF, TAIL_IN1 = 0;
__device__ __forceinline__ void dbg_dump(int k, int off, float* out, const bf16* UB, const bf16* PROJ, const bf16* KC, int gw, int ngw) {
    const int ln = threadIdx.x & 63;
    if (k == 3 || k == 6) { for (size_t i = (size_t)gw * 64 + ln; i < (size_t)SEQ * DM; i += (size_t)ngw * 64) out[i] = bf2f(UB[i]); }
    else if (k == 4) { for (size_t i = (size_t)gw * 64 + ln; i < (size_t)SEQ * DM; i += (size_t)ngw * 64) { const size_t m = i / DM, n = i % DM; out[i] = bf2f(PVEC(PROJ, (off + n) & ~127)[m * 128 + ((off + n) & 127)]); } }
    else if (k == 5) { for (size_t i = (size_t)gw * 64 + ln; i < (size_t)SEQ * DM; i += (size_t)ngw * 64) out[i] = bf2f(KC[i & 524287]); }
}
struct Args { const float* in[25]; float* out; unsigned char* ws; int stop_after; int dump_off; };
__global__ void __launch_bounds__(NWAVES * 64, 2) mk_fwd(Args args) {
    extern __shared__ __attribute__((aligned(16))) unsigned char lds[];
    LAS unsigned char* ldsl = (LAS unsigned char*)lds;
    const int tid = threadIdx.x, wave = __builtin_amdgcn_readfirstlane(tid >> 6);
#define lane ((int)(threadIdx.x & 63u))
    const int G = gridDim.x, bx = blockIdx.x, vcu = (G % 8 == 0) ? (bx % 8) * (G / 8) + bx / 8 : bx;
    const int gw = vcu * NWAVES + wave, ngw = G * NWAVES;
    unsigned char* ws = args.ws;
    gu32* ctl = (gu32*)(ws + WS_CTL);
    for (int u = tid; u < (LDS_BYTES - LDSCTL_OFF) / 4; u += NWAVES * 64) ((LAS unsigned*)(ldsl + LDSCTL_OFF))[u] = 0u;
    __syncthreads();
    XcdBarrier bar = xcd_barrier_post((unsigned*)(ctl + CW_BAR), (volatile LAS unsigned*)(ldsl + MISC_OFF) + 8);
    float* h = args.out;
    bf16* UB = (bf16*)(ws + WS_UB); bf16* HID = (bf16*)(ws + WS_HID); bf16* PROJ = (bf16*)(ws + WS_HID);
    bf16* KC = (bf16*)(ws + WS_KC); bf16* VC = (bf16*)(ws + WS_VC);
    float* scr = (float*)(ws + WS_SCR) + (size_t)bx * 65536;
    const int stop = args.stop_after;
#define SEAM(k) do { xcd_barrier(bar); if (stop == (k)) { dbg_dump((k), args.dump_off, h, UB, PROJ, KC, gw, ngw); return; } } while (0)

#ifndef NO_P0
    for (int rep_ = 0; rep_ < REP_P0; ++rep_) {
        LAS float* tscr = (LAS float*)(ldsl + wave * 16640);
        tr_matrix(args.in[2], DM, DFF, (bf16*)(ws + WS_WGU1), 1, tscr, gw, ngw, lane, 2);
        tr_matrix(args.in[3], DM, DFF, (bf16*)(ws + WS_WGU1), 2, tscr, gw, ngw, lane, 2);
        tr_range(args.in[4], DFF, DM, (bf16*)(ws + WS_WD1), 0, tscr, TAIL_DN1, ITEMS_FF, gw, ngw, lane, 1);
        tr_range(args.in[6], DM, NIN, (bf16*)(ws + WS_WIN), 0, tscr, TAIL_IN1, ITEMS_IN, gw, ngw, lane, 2);
        tr_range(args.in[23], DFF, DM, (bf16*)(ws + WS_WD2), 0, tscr, TAIL_DN2, ITEMS_FF, gw, ngw, lane, 1);
        tile_w1(args.in[14], (bf16*)(ws + WS_W1K), gw, ngw, lane);
        tile_w1(args.in[17], (bf16*)(ws + WS_W1V), gw, ngw, lane);
        tr_matrix(args.in[15], 256, 128, (bf16*)(ws + WS_W2K), 0, tscr, gw, ngw, lane, 0);
        tr_matrix(args.in[18], 256, 128, (bf16*)(ws + WS_W2V), 0, tscr, gw, ngw, lane, 0);
        rms_rows_bf16(args.in[0], args.in[1], UB, gw, ngw, lane);
    }
#endif
    SEAM(0);
#ifndef NO_GEMM
    for (int rep_ = 0; rep_ < REP_P1; ++rep_) {
        pg8::Gemm g{UB, (const bf16*)(ws + WS_WGU1), SEQ, 2 * DFF, DM, 0, 1}; pg8::StaticOrder S; S.init(SEQ, 2 * DFF, G, bx);
        pg8::EpiSwiGLU E{HID, DFF, 1};
        pg8::gemm_phase<pg8::EpiSwiGLU, pg8::StaticOrder, true, true>(ldsl, g, S, E);
        { constexpr int NU = (SEQ / 256) * (2 * DFF / 256); const int nfull = NU % G;
          const int tw_ = nfull ? (bx - nfull) * NWAVES + wave : gw, tn_ = nfull ? (G - nfull) * NWAVES : ngw;
          if (rep_ == 0 && (!nfull || bx >= nfull)) { tr_range(args.in[4], DFF, DM, (bf16*)(ws + WS_WD1), 0, (LAS float*)(ldsl + wave * 16640), 0, TAIL_DN1, tw_, tn_, lane, 1);
              tr_range(args.in[6], DM, NIN, (bf16*)(ws + WS_WIN), 0, (LAS float*)(ldsl + wave * 16640), 0, TAIL_IN1, tw_, tn_, lane, 2); } }
    }
#endif
    SEAM(1);
#ifndef NO_GEMM
    {
        pg8::Gemm g{HID, (const bf16*)(ws + WS_WD1), SEQ, DM, DFF, 1, 1}; pg8::StaticOrder S; S.init(SEQ, DM, G, bx);
        pg8::EpiResF32 E{args.in[0], h, DM, 0.5f};
        pg8::gemm_phase<pg8::EpiResF32, pg8::StaticOrder, true, true>(ldsl, g, S, E);
    }
#endif
    SEAM(2);
    rms_rows_bf16(h, args.in[5], UB, gw, ngw, lane);
    SEAM(3);
#ifndef NO_GEMM
    {
        pg8::Gemm g{UB, (const bf16*)(ws + WS_WIN), SEQ, LDP, DM, 0, 1}; pg8::StaticOrder S; S.init(SEQ, LDP, G, bx);
        pg8::EpiProj E{PROJ, LDP, OFF_DQ, OFF_DK, OFF_NQ, OFF_KC, QSCALE};
        pg8::gemm_phase<pg8::EpiProj, pg8::StaticOrder, true, true>(ldsl, g, S, E);
        { constexpr int NU = (SEQ / 256) * (LDP / 256); const int nfull = NU % G;
          const int tw_ = nfull ? (bx - nfull) * NWAVES + wave : gw, tn_ = nfull ? (G - nfull) * NWAVES : ngw;
          if (!nfull || bx >= nfull) { tr_range(args.in[22], DM, DFF, (bf16*)(ws + WS_WGU2), 2, (LAS float*)(ldsl + wave * 16640), 0, TAIL_UP2, tw_, tn_, lane, 2);
              tr_range(args.in[21], DM, DFF, (bf16*)(ws + WS_WGU2), 1, (LAS float*)(ldsl + wave * 16640), TAIL_GT2, ITEMS_FF, tw_, tn_, lane, 2); } }
    }
#endif
    SEAM(4);
    norm_pass(PROJ, (float*)(ctl + CW_NORM), bx, G, (char*)lds);
    const bool split8 = (G == 256);
    const int xcd5 = bx & 7, slot5 = bx >> 3;
    const int ctask = split8 ? (slot5 < 16 ? (xcd5 >> 2) * 64 + (xcd5 & 3) * 16 + slot5 : 128) : vcu;
    const int cstep = split8 ? 128 : G;
#ifndef NO_CMP
    for (int rep_ = 0; rep_ < REP_P5; ++rep_)
    for (int task = ctask; task < 128; task += cstep) {
        const int kv = task >> 6, rb = task & 63;
        compress_task(PROJ, kv ? OFF_VC : OFF_KC, kv ? args.in[16] : args.in[13], (const bf16*)(ws + (kv ? WS_W1V : WS_W1K)), (const bf16*)(ws + (kv ? WS_W2V : WS_W2K)), kv ? VC : KC, rb,
                      (char*)lds, wave, lane);
    }
#endif
    if (split8 ? slot5 >= 16 : (vcu >= 128 || G <= 128)) {
        const int tw5_ = split8 ? ((slot5 - 16) * 8 + xcd5) * NWAVES + wave : (G > 128 ? (vcu - 128) * NWAVES + wave : gw), tn5_ = split8 ? 128 * NWAVES : (G > 128 ? (G - 128) * NWAVES : ngw);
        tr_range(args.in[23], DFF, DM, (bf16*)(ws + WS_WD2), 0, (LAS float*)(ldsl + wave * 16640), TAIL_DN9, TAIL_DN2, tw5_, tn5_, lane, 1);
        tr_range(args.in[21], DM, DFF, (bf16*)(ws + WS_WGU2), 1, (LAS float*)(ldsl + wave * 16640), 0, TAIL_GT2, tw5_, tn5_, lane, 2);
        tr_range(args.in[19], DM, DM, (bf16*)(ws + WS_WOUT), 0, (LAS float*)(ldsl + wave * 16640), 0, (DM / 64) * (DM / 64), tw5_, tn5_, lane, 1); }
    SEAM(5);
    {
        float lam;
        { const float a1 = wave_sum(args.in[8][lane] * args.in[9][lane] + args.in[8][lane + 64] * args.in[9][lane + 64]);
          const float a2 = wave_sum(args.in[10][lane] * args.in[11][lane] + args.in[10][lane + 64] * args.in[11][lane + 64]);
          lam = __expf(a1) - __expf(a2) + LAM0; }
        float* dcutL = (float*)((char*)lds + LDSCTL_OFF + 768);
        { float m = 0.f; const float* slots = (const float*)(ctl + CW_NORM);
          for (int w = tid >> 5; w < G; w += 16) m = fmaxf(m, slots[w * 32 + (tid & 31)]);
          float* red = (float*)lds; red[tid] = m; __syncthreads();
          if (tid < 32) { float mm = red[tid];
#pragma unroll
              for (int p = 1; p < 16; ++p) mm = fmaxf(mm, red[p * 32 + tid]);
              red[512 + tid] = mm; }
          __syncthreads();
          if (tid < 8) { const float qm = fmaxf(red[512 + 2 * tid], red[513 + 2 * tid]), km = fmaxf(red[528 + 2 * tid], red[529 + 2 * tid]);
              dcutL[tid] = (2.0f * qm * km + 70.0f) / (__builtin_amdgcn_exp2f(-(float)(tid + 1)) * LOG2E); }
          __syncthreads();
          unsigned char* segL = (unsigned char*)lds + LDSCTL_OFF + 512;
          float* W = (float*)((char*)lds + 4096); int* ord = (int*)((char*)lds + 4160); float* load = (float*)((char*)lds + 4224); int* ns = (int*)((char*)lds + 4256);
#pragma unroll
          for (int k = 0; k < 2; ++k) { const int s_ = 2 * wave + k, qq = lane; const float fl = ((float)(128 * qq) - dcutL[s_ >> 1]) * (1.0f / 64.0f);
              const float tot = wave_sum((float)(2 * (qq + 1) - (fl > 0.f ? (int)fl : 0)));
              if (lane == 0) W[s_] = tot; }
          __syncthreads();
          if (tid < 16) { const float me = W[tid]; int rank = 0;
              for (int j = 0; j < 16; ++j) { const float o_ = W[j]; rank += (o_ > me || (o_ == me && j < tid)) ? 1 : 0; }
              ord[rank] = tid; }
          __syncthreads();
          if (tid == 0) {
              for (int x = 0; x < 8; ++x) { load[x] = 0.f; ns[x] = 0; }
              for (int a = 0; a < 16; ++a) { int bx_ = 0; for (int x = 1; x < 8; ++x) if (load[x] < load[bx_]) bx_ = x;
                  segL[bx_ * 16 + ns[bx_]] = (unsigned char)ord[a]; ns[bx_]++; load[bx_] += W[ord[a]]; }
              for (int x = 0; x < 8; ++x) segL[128 + x] = (unsigned char)ns[x];
          }
          __syncthreads(); }
        volatile LAS unsigned* qw = (volatile LAS unsigned*)(ldsl + MISC_OFF) + 12;
        const int myx = (int)(xb_xcc_id() & 7u);
        for (int rep_ = 0; rep_ < REP_DIFF; ++rep_) {
#pragma unroll 1
        for (int dx = 0; dx < 8; ++dx) {
            const int x = (myx + dx) & 7;
            const int nsg = __builtin_amdgcn_readfirstlane((int)((unsigned char*)lds + LDSCTL_OFF + 512)[128 + x]), len = 64 * nsg + 64;
#pragma unroll 1
            for (;;) {
                if (tid == 0) qw[0] = __hip_atomic_fetch_add((unsigned*)(ctl + CW_QUEUE) + 64 * (8 * rep_ + x), 1u, __ATOMIC_RELAXED, __HIP_MEMORY_SCOPE_AGENT);
                __syncthreads();
                const int u = __builtin_amdgcn_readfirstlane((int)qw[0]);
                __syncthreads();
                if (u >= len) break;
                if (u >= 64) {
#ifndef NO_DIFF
                    if (rep_ >= 1 && (REP_ONLY == 2 || REP_ONLY >= 64)) continue;
                    const int st = __builtin_amdgcn_readfirstlane((int)((unsigned char*)lds + LDSCTL_OFF + 512)[x * 16 + ((u - 64) >> 6)]), hh = st >> 1, qt = 63 - (u & 63);
                    const float fl = ((float)(128 * qt) - dcutL[hh]) * (1.0f / 64.0f);
                    const int jlo = __builtin_amdgcn_readfirstlane(fl > 0.f ? (int)fl : 0);
                    diff_job(PROJ, UB, (float*)(ws + WS_DPART), (unsigned*)(ctl + CW_DCNT) + 32768 * rep_, args.in[12], lam, hh, qt, st & 1, jlo, (char*)lds, qw, (rep_ >= 1 && REP_ONLY >= 3) ? REP_ONLY - 2 : 0);
#endif
                } else {
#ifndef NO_NSA
                    if (rep_ >= 1 && (REP_ONLY == 1 || (REP_ONLY >= 3 && REP_ONLY < 64))) continue;
                    const int j = u;
                    nsa_unit(PROJ, KC, VC, UB, scr, args.in[7], x >> 1, 127 - 2 * j - (x & 1), (char*)lds, (rep_ >= 1 && REP_ONLY >= 64) ? REP_ONLY - 64 : 0);
#endif
                }
            }
        } }
    }
    SEAM(6);
#ifndef NO_GEMM
    {
        pg8::Gemm g{UB, (const bf16*)(ws + WS_WOUT), SEQ, DM, DM, 0, 1}; pg8::StaticOrder S; S.init(SEQ, DM, G, bx);
        pg8::EpiResF32 E{h, h, DM, 1.0f};
        pg8::gemm_phase<pg8::EpiResF32, pg8::StaticOrder, true, true>(ldsl, g, S, E);
    }
#endif
    SEAM(7);
    rms_rows_bf16(h, args.in[20], UB, gw, ngw, lane);
    SEAM(8);
#ifndef NO_GEMM
    {
        pg8::Gemm g{UB, (const bf16*)(ws + WS_WGU2), SEQ, 2 * DFF, DM, 0, 1}; pg8::StaticOrder S; S.init(SEQ, 2 * DFF, G, bx);
        pg8::EpiSwiGLU E{HID, DFF, 1};
        pg8::gemm_phase<pg8::EpiSwiGLU, pg8::StaticOrder, true, true>(ldsl, g, S, E);
        { constexpr int NU = (SEQ / 256) * (2 * DFF / 256); const int nfull = NU % G;
          const int tw_ = nfull ? (bx - nfull) * NWAVES + wave : gw, tn_ = nfull ? (G - nfull) * NWAVES : ngw;
          if (!nfull || bx >= nfull) tr_range(args.in[23], DFF, DM, (bf16*)(ws + WS_WD2), 0, (LAS float*)(ldsl + wave * 16640), 0, TAIL_DN9, tw_, tn_, lane, 1); }
    }
#endif
    SEAM(9);
#ifndef NO_GEMM
    {
        pg8::Gemm g{HID, (const bf16*)(ws + WS_WD2), SEQ, DM, DFF, 1, 1}; pg8::StaticOrder S; S.init(SEQ, DM, G, bx);
        pg8::EpiResF32 E{h, h, DM, 0.5f};
        pg8::gemm_phase<pg8::EpiResF32, pg8::StaticOrder, true, true>(ldsl, g, S, E);
    }
#endif
    SEAM(10);
    rms_rows_f32(h, args.in[24], gw, ngw, lane);
#undef SEAM
#undef lane
}

extern "C" void kernel_launch(void* const* d_in, const int* in_sizes, int n_in, void* d_out, int out_size, void* d_ws, size_t ws_size, hipStream_t stream) {
    static int grid = 0;
    if (grid == 0) {
        if (n_in != 25 || in_sizes[0] != SEQ * DM || out_size != SEQ * DM || ws_size < WS_END) {
            fprintf(stderr, "kernel_launch: built for 25 inputs, x/out of %d floats, >= %zu bytes of workspace; got n_in %d, in0 %d, out %d, ws %zu; nothing launched\n", SEQ * DM, (size_t)WS_END, n_in, n_in > 0 ? in_sizes[0] : -1, out_size, ws_size);
            grid = -1; return; }
        int dev = 0, cus = 0, per_cu = 0;
        if (hipGetDevice(&dev) != hipSuccess || hipDeviceGetAttribute(&cus, hipDeviceAttributeMultiprocessorCount, dev) != hipSuccess) { fprintf(stderr, "kernel_launch: device query failed\n"); grid = -1; return; }
        if (hipFuncSetAttribute((const void*)mk_fwd, hipFuncAttributeMaxDynamicSharedMemorySize, LDS_BYTES) != hipSuccess) { fprintf(stderr, "kernel_launch: hipFuncSetAttribute failed\n"); grid = -1; return; }
        if (hipOccupancyMaxActiveBlocksPerMultiprocessor(&per_cu, (const void*)mk_fwd, NWAVES * 64, LDS_BYTES) != hipSuccess || per_cu < 1)
            fprintf(stderr, "kernel_launch: note: occupancy query reports %d workgroups per CU\n", per_cu);
        (void)hipGetLastError();
        grid = cus;
    }
    if (grid < 0) return;
    if (hipMemsetAsync((char*)d_ws + WS_CTL, 0, CTL_ZERO_BYTES, stream) != hipSuccess) { fprintf(stderr, "kernel_launch: memset failed\n"); return; }
    Args a{};
    for (int i = 0; i < 25; ++i) a.in[i] = (const float*)d_in[i];
    a.out = (float*)d_out; a.ws = (unsigned char*)d_ws; a.stop_after = STOP_AFTER; a.dump_off = DUMP_OFF;
    hipLaunchKernelGGL(mk_fwd, dim3(grid), dim3(NWAVES * 64), LDS_BYTES, stream, a);
    const hipError_t le = hipPeekAtLastError();
    if (le != hipSuccess) fprintf(stderr, "kernel_launch: launch failed: %s\n", hipGetErrorName(le));
}
```

```cpp
#include <hip/hip_runtime.h>
#include <cstdio>
#include <cstdint>
#ifndef DBG_STAGE
#define DBG_STAGE 0
#endif
namespace pg8 {
#define PG8_LAS __attribute__((address_space(3)))
typedef unsigned short bf16_t;
typedef short bf16x8 __attribute__((ext_vector_type(8)));
typedef float f32x4 __attribute__((ext_vector_type(4)));
typedef unsigned u32x4 __attribute__((ext_vector_type(4)));
constexpr int BM = 256, BK = 64, HALF = 128, HTB = HALF * BK * 2  , STAGE_BYTES = 8 * HTB, NXCD = 8, WGM = 8;

__host__ __device__ __forceinline__ int lds_byte(int r, int c) { const int st = (r >> 4) * 2 + (c >> 5), rr = r & 15, cc = c & 31, ob = rr * 64 + cc * 2; return st * 1024 + (ob ^ (((ob >> 9) & 1) << 5)); }
__host__ __device__ __forceinline__ void stage_rc(int b, int& R, int& C) { const int st = b / 1024, sb = b % 1024, swz = sb ^ (((sb >> 9) & 1) << 5); R = (st >> 1) * 16 + swz / 64; C = (st & 1) * 32 + (swz % 64) / 2; }
__host__ __device__ __forceinline__ int perm32(int rho) { const int n = rho >> 4, i = rho & 15; return 8 * (i >> 2) + 4 * n + (i & 3); }

struct Unit { int pm, pn; };
struct Gemm { const bf16_t* A; const bf16_t* Bt; int M, N, K; int imgA = 0, imgB = 0; };

struct StaticOrder {
    int nM, nN, nwg, G, c;
    __host__ __device__ void init(int M, int N, int G_, int c_) { nM = M / BM; nN = N / BM; nwg = nM * nN; G = G_; c = c_; }
    __host__ __device__ bool next(int i, Unit& u) const {
        const long L = (long)i * G + c; if (L >= nwg) return false;
        int wgid = (int)L; { const int q = nwg / NXCD, r = nwg % NXCD, xcd = wgid % NXCD, off = wgid / NXCD; wgid = (xcd < r ? xcd * (q + 1) : r * (q + 1) + (xcd - r) * q) + off; }
        const int nig = WGM * nN, gid = wgid / nig, fm = gid * WGM, gsz = (nM - fm) < WGM ? (nM - fm) : WGM;
        u.pm = fm + ((wgid % nig) % gsz); u.pn = (wgid % nig) / gsz; return true;
    }
    __device__ __forceinline__ void a_ready(const Unit&) const {}
    __device__ __forceinline__ void done(const Unit&) const {}
};
typedef float f32x2c_t __attribute__((ext_vector_type(2))); typedef __bf16 bf16x2c_t __attribute__((ext_vector_type(2)));
__device__ __forceinline__ unsigned cvt_pk_bf16(float lo, float hi) { f32x2c_t v = {lo, hi}; bf16x2c_t b = __builtin_convertvector(v, bf16x2c_t); return __builtin_bit_cast(unsigned, b); }
typedef float f32x2 __attribute__((ext_vector_type(2)));
struct EpiSwiGLU {
    static constexpr bool PERM = true, AFTER_DRAIN = false;
    bf16_t* O; int ldc; int img;
    __device__ __forceinline__ void operator()(const f32x4 (&acc)[2][2][4][2], const Unit& u, int wr, int wc, int fr, int fq) const {
        const int row0 = u.pm * BM + wr * 64 + fr, col0 = u.pn * HALF + wc * 32 + 8 * fq;
        const int ntk = ldc >> 6;
#pragma unroll
        for (int ai = 0; ai < 2; ++ai)
#pragma unroll
            for (int m = 0; m < 4; ++m) { bf16_t* rowp = img ? (bf16_t*)((char*)O + ((size_t)(u.pm * 2 + ai) * ntk + (col0 >> 6)) * 16384 + lds_byte(wr * 64 + m * 16 + fr, col0 & 63))
                                                    : O + (size_t)(row0 + ai * HALF + m * 16) * ldc + col0;
                float v[8];
#pragma unroll
                for (int n = 0; n < 2; ++n)
#pragma unroll
                    for (int j = 0; j < 4; ++j) { const float g = acc[ai][0][m][n][j], up = acc[ai][1][m][n][j];
                        const float e = __builtin_amdgcn_exp2f(g * -1.4426950408889634f); v[4 * n + j] = g * __builtin_amdgcn_rcpf(1.0f + e) * up; }
                u32x4 w; w.x = cvt_pk_bf16(v[0], v[1]); w.y = cvt_pk_bf16(v[2], v[3]); w.z = cvt_pk_bf16(v[4], v[5]); w.w = cvt_pk_bf16(v[6], v[7]);
                *(u32x4*)rowp = w; }
    }
};
struct EpiResF32 {
    static constexpr bool PERM = false, AFTER_DRAIN = false;
    const float* base; float* out; int ldc; float alpha;
    __device__ __forceinline__ void operator()(const f32x4 (&acc)[2][2][4][2], const Unit& u, int wr, int wc, int fr, int fq) const {
        const int row0 = u.pm * BM + wr * 64 + fr, col0 = u.pn * BM + wc * 32 + 4 * fq;
#pragma unroll
        for (int ai = 0; ai < 2; ++ai)
#pragma unroll
            for (int m = 0; m < 4; ++m) { const size_t off = (size_t)(row0 + ai * HALF + m * 16) * ldc + col0;
#pragma unroll
                for (int bj = 0; bj < 2; ++bj)
#pragma unroll
                    for (int n = 0; n < 2; ++n) { const f32x4 b = *(const f32x4*)(base + off + bj * HALF + n * 16); *(f32x4*)(out + off + bj * HALF + n * 16) = b + acc[ai][bj][m][n] * alpha; }
                asm volatile("" ::: "memory"); }
    }
};
struct EpiProj {
    static constexpr bool PERM = true, AFTER_DRAIN = false;
    bf16_t* O; int ldc; int q0a, q0b, q1a, q1b; float qscale;
    __device__ __forceinline__ void operator()(const f32x4 (&acc)[2][2][4][2], const Unit& u, int wr, int wc, int fr, int fq) const {
        const int row0 = u.pm * BM + wr * 64 + fr, colt = u.pn * BM, col0 = colt + wc * 32 + 8 * fq;
        const float sc = ((colt >= q0a && colt < q0b) || (colt >= q1a && colt < q1b)) ? qscale : 1.0f;
#pragma unroll
        for (int ai = 0; ai < 2; ++ai)
#pragma unroll
            for (int m = 0; m < 4; ++m) { bf16_t* rowp = O + (size_t)(colt >> 7) * ((size_t)8192 * 128) + (size_t)(row0 + ai * HALF + m * 16) * 128 + wc * 32 + 8 * fq;
#pragma unroll
                for (int bj = 0; bj < 2; ++bj) { const f32x4 v0 = acc[ai][bj][m][0] * sc, v1 = acc[ai][bj][m][1] * sc;
                    u32x4 w; w.x = cvt_pk_bf16(v0[0], v0[1]); w.y = cvt_pk_bf16(v0[2], v0[3]); w.z = cvt_pk_bf16(v1[0], v1[1]); w.w = cvt_pk_bf16(v1[2], v1[3]);
                    *(u32x4*)(rowp + (size_t)bj * ((size_t)8192 * 128)) = w; } }
    }
};
template <class Epi, class Sched, bool ALIGN_EPI = false, bool SP2 = false>
__device__ __forceinline__ void gemm_phase(PG8_LAS unsigned char* lds, const Gemm g, const Sched& S, const Epi& E) {
    int tid_ = threadIdx.x; asm volatile("" : "+v"(tid_));
    const int tid = tid_, wid = __builtin_amdgcn_readfirstlane(tid >> 6), lane = tid & 63, wr = wid >> 2, wc = wid & 3, fr = lane & 15, fq = lane >> 4;
    const int K = g.K, nt = K / BK;
    unsigned voffA[2], voffB[2];
#pragma unroll
    for (int i = 0; i < 2; ++i) { int R, C; stage_rc(tid * 16 + i * 8192, R, C); const int Rb = Epi::PERM ? ((R & ~31) + perm32(R & 31)) : R;
        voffA[i] = g.imgA ? (unsigned)(tid * 16 + i * 8192) : (unsigned)(R * K + C) * 2u; voffB[i] = g.imgB ? (unsigned)(tid * 16 + i * 8192) : (unsigned)(Rb * K + C) * 2u; }
    const size_t kstA = g.imgA ? (size_t)HTB : (size_t)(BK * 2), kstB = g.imgB ? (size_t)HTB : (size_t)(BK * 2);
    const size_t hstA = g.imgA ? (size_t)HTB * nt : (size_t)HALF * K * 2, hstB = g.imgB ? (size_t)HTB * nt : (size_t)HALF * K * 2;
    const size_t tstA = 2 * hstA, tstB = 2 * hstB;
    const unsigned ldsw = (unsigned)wid * 1024u;
    const int aoff = lds_byte(wr * 64 + fr, fq * 8), boff = lds_byte(wc * 32 + fr, fq * 8);
#define PG8_SA(b, h) (((b) * 2 + (h)) * HTB)
#define PG8_SB(b, h) ((4 + (b) * 2 + (h)) * HTB)
#define PG8_STAGE(bufoff, gbase, voff) do { _Pragma("unroll") for (int _i = 0; _i < 2; ++_i) \
        __builtin_amdgcn_global_load_lds((const unsigned*)((const char*)(gbase) + (voff)[_i]), (PG8_LAS unsigned*)(lds + (bufoff) + ldsw + _i * 8192), 16, 0, 0); } while (0)
#define PG8_LDA(dst, b, h) do { _Pragma("unroll") for (int m = 0; m < 4; ++m) _Pragma("unroll") for (int k = 0; k < 2; ++k) dst[m][k] = *(const PG8_LAS bf16x8*)(lds + PG8_SA(b, h) + aoff + m * 2048 + k * 1024); } while (0)
#define PG8_LDB(dst, b, h) do { _Pragma("unroll") for (int n = 0; n < 2; ++n) _Pragma("unroll") for (int k = 0; k < 2; ++k) dst[n][k] = *(const PG8_LAS bf16x8*)(lds + PG8_SB(b, h) + boff + n * 2048 + k * 1024); } while (0)
#define PG8_MMA(ai, bj, At, Bt) do { __builtin_amdgcn_s_setprio(1); _Pragma("unroll") for (int m = 0; m < 4; ++m) _Pragma("unroll") for (int n = 0; n < 2; ++n) _Pragma("unroll") for (int k = 0; k < 2; ++k) \
        acc[ai][bj][m][n] = __builtin_amdgcn_mfma_f32_16x16x32_bf16(Bt[n][k], At[m][k], acc[ai][bj][m][n], 0, 0, 0); __builtin_amdgcn_s_setprio(0); } while (0)
#define PG8_WAIT_V(n) asm volatile("s_waitcnt vmcnt(" #n ")" ::: "memory")
#define PG8_WAIT_L(n) asm volatile("s_waitcnt lgkmcnt(" #n ")" ::: "memory")
#define PG8_BAR __builtin_amdgcn_s_barrier()
#define PG8_SCHED __builtin_amdgcn_sched_barrier(0)
    Unit cur, nxt; int ui = 0;
    if (!S.next(0, cur)) return;
    f32x4 acc[2][2][4][2];
#pragma unroll
    for (int a = 0; a < 2; ++a)
#pragma unroll
        for (int b = 0; b < 2; ++b)
#pragma unroll
            for (int m = 0; m < 4; ++m)
#pragma unroll
                for (int n = 0; n < 2; ++n) acc[a][b][m][n] = (f32x4){0.f, 0.f, 0.f, 0.f};
    bf16x8 At[4][2], B0[2][2], B1[2][2];
    const char* cA = (const char*)g.A + (size_t)cur.pm * tstA; const char* cB = (const char*)g.Bt + (size_t)cur.pn * tstB;
    S.a_ready(cur);
    if constexpr (SP2) {
        PG8_STAGE(PG8_SB(0, 0), cB, voffB); PG8_STAGE(PG8_SB(0, 1), cB + hstB, voffB); PG8_STAGE(PG8_SA(0, 0), cA, voffA); PG8_STAGE(PG8_SA(0, 1), cA + hstA, voffA);
        if (wr == 1) PG8_BAR;
        PG8_WAIT_V(2); PG8_BAR;
        PG8_STAGE(PG8_SB(1, 0), cB + kstB, voffB); PG8_STAGE(PG8_SA(1, 0), cA + kstA, voffA); PG8_STAGE(PG8_SB(1, 1), cB + hstB + kstB, voffB);
        PG8_WAIT_V(6); PG8_BAR;
    } else {
        PG8_STAGE(PG8_SB(0, 0), cB, voffB); PG8_STAGE(PG8_SA(0, 0), cA, voffA); PG8_STAGE(PG8_SB(0, 1), cB + hstB, voffB); PG8_STAGE(PG8_SA(0, 1), cA + hstA, voffA);
        if (wr == 1) PG8_BAR;
        PG8_WAIT_V(4); PG8_BAR;
        PG8_STAGE(PG8_SB(1, 0), cB + kstB, voffB); PG8_STAGE(PG8_SA(1, 0), cA + kstA, voffA); PG8_STAGE(PG8_SB(1, 1), cB + hstB + kstB, voffB);
        PG8_WAIT_V(6); PG8_BAR;
    }
    for (;;) {
        const bool has_next = S.next(ui + 1, nxt);
        const char* nA = has_next ? (const char*)g.A + (size_t)nxt.pm * tstA : cA; const char* nB = has_next ? (const char*)g.Bt + (size_t)nxt.pn * tstB : cB;
        for (int t = 0; t < nt; t += 2) {
            const bool last = (t == nt - 2);
            const char* a1 = cA + (size_t)(t + 1) * kstA;
            const char* a2 = last ? nA : cA + (size_t)(t + 2) * kstA; const char* b2 = last ? nB : cB + (size_t)(t + 2) * kstB;
            const char* a3 = a2 + kstA; const char* b3 = b2 + kstB;
            if (last && has_next) S.a_ready(nxt);
            if constexpr (SP2) {
            PG8_LDB(B0, 0, 0); PG8_LDB(B1, 0, 1); PG8_SCHED; PG8_LDA(At, 0, 0); PG8_STAGE(PG8_SA(1, 1), a1 + hstA, voffA);
            PG8_WAIT_V(8); PG8_WAIT_L(0); PG8_BAR; PG8_MMA(0, 0, At, B0); PG8_MMA(0, 1, At, B1); PG8_BAR; PG8_SCHED;
            PG8_LDA(At, 0, 1); PG8_STAGE(PG8_SB(0, 0), b2, voffB); PG8_STAGE(PG8_SB(0, 1), b2 + hstB, voffB); PG8_STAGE(PG8_SA(0, 0), a2, voffA);
            PG8_WAIT_V(8); PG8_WAIT_L(0); PG8_BAR; PG8_MMA(1, 0, At, B0); PG8_MMA(1, 1, At, B1); PG8_BAR; PG8_SCHED;
            PG8_LDB(B0, 1, 0); PG8_LDB(B1, 1, 1); PG8_SCHED; PG8_LDA(At, 1, 0); PG8_STAGE(PG8_SA(0, 1), a2 + hstA, voffA);
            PG8_WAIT_V(8); PG8_WAIT_L(0); PG8_BAR; PG8_MMA(0, 0, At, B0); PG8_MMA(0, 1, At, B1); PG8_BAR; PG8_SCHED;
            PG8_LDA(At, 1, 1); PG8_STAGE(PG8_SB(1, 0), b3, voffB); PG8_STAGE(PG8_SB(1, 1), b3 + hstB, voffB); PG8_STAGE(PG8_SA(1, 0), a3, voffA);
            PG8_WAIT_V(8); PG8_WAIT_L(0); PG8_BAR; PG8_MMA(1, 0, At, B0); PG8_MMA(1, 1, At, B1); PG8_BAR; PG8_SCHED;
            } else {
            PG8_LDB(B0, 0, 0); PG8_SCHED; PG8_LDA(At, 0, 0); PG8_STAGE(PG8_SA(1, 1), a1 + hstA, voffA);
            PG8_WAIT_L(8); PG8_BAR; PG8_WAIT_L(0); PG8_MMA(0, 0, At, B0); PG8_BAR; PG8_SCHED;
            PG8_LDB(B1, 0, 1); PG8_STAGE(PG8_SB(0, 0), b2, voffB);
            PG8_BAR; PG8_WAIT_L(0); PG8_MMA(0, 1, At, B1); PG8_BAR;
            PG8_LDA(At, 0, 1); PG8_STAGE(PG8_SA(0, 0), a2, voffA);
            PG8_BAR; PG8_WAIT_L(0); PG8_MMA(1, 0, At, B0); PG8_BAR; PG8_SCHED;
            PG8_STAGE(PG8_SB(0, 1), b2 + hstB, voffB);
            PG8_WAIT_V(6); PG8_BAR; PG8_MMA(1, 1, At, B1); PG8_BAR;
            PG8_LDB(B0, 1, 0); PG8_SCHED; PG8_LDA(At, 1, 0); PG8_STAGE(PG8_SA(0, 1), a2 + hstA, voffA);
            PG8_WAIT_L(8); PG8_BAR; PG8_WAIT_L(0); PG8_MMA(0, 0, At, B0); PG8_BAR; PG8_SCHED;
            PG8_LDB(B1, 1, 1); PG8_STAGE(PG8_SB(1, 0), b3, voffB);
            PG8_BAR; PG8_WAIT_L(0); PG8_MMA(0, 1, At, B1); PG8_BAR;
            PG8_LDA(At, 1, 1); PG8_STAGE(PG8_SA(1, 0), a3, voffA);
            PG8_BAR; PG8_WAIT_L(0); PG8_MMA(1, 0, At, B0); PG8_BAR; PG8_SCHED;
            PG8_STAGE(PG8_SB(1, 1), b3 + hstB, voffB);
            PG8_WAIT_V(6); PG8_BAR; PG8_MMA(1, 1, At, B1); PG8_BAR;
            }
        }
        if constexpr (ALIGN_EPI) { if (wr == 0) PG8_BAR; }
        if constexpr (!Epi::AFTER_DRAIN) { E(acc, cur, wr, wc, fr, fq); S.done(cur); }
        if (!has_next) break;
#pragma unroll
        for (int a = 0; a < 2; ++a)
#pragma unroll
            for (int b = 0; b < 2; ++b)
#pragma unroll
                for (int m = 0; m < 4; ++m)
#pragma unroll
                    for (int n = 0; n < 2; ++n) acc[a][b][m][n] = (f32x4){0.f, 0.f, 0.f, 0.f};
        cur = nxt; cA = nA; cB = nB; ++ui;
        if constexpr (ALIGN_EPI) { if (wr == 1) PG8_BAR; }
    }
    PG8_WAIT_V(0);
    if constexpr (!ALIGN_EPI) { if (wr == 0) PG8_BAR; }
    PG8_BAR;
    if constexpr (Epi::AFTER_DRAIN) { E.fused(acc, cur, wr, wc, fr, fq, lds, wid, lane); S.done(cur); }
#undef PG8_SA
#undef PG8_SB
#undef PG8_STAGE
#undef PG8_LDA
#undef PG8_LDB
#undef PG8_MMA
#undef PG8_WAIT_V
#undef PG8_WAIT_L
#undef PG8_BAR
#undef PG8_SCHED
}
}
constexpr int SEQ = 8192, DM = 4096, DFF = 11008, NIN = 11312, LDP = 11520;
constexpr int HD = 128, DIFF_H = 8, NSA_H = 16, NSA_KV = 4;
constexpr int OFF_DQ = 0, OFF_DK = 2048, OFF_DV = 4096, OFF_NQ = 6144, OFF_KC = 8192, OFF_VC = 8704, OFF_KS = 9216, OFF_VS = 9728, OFF_KW = 10240, OFF_VW = 10752, OFF_G = 11264;
#define PVEC(p, col) ((p) + (size_t)((col) >> 7) * ((size_t)SEQ * 128))
constexpr float EPS = 1e-6f, LOG2E = 1.4426950408889634f, QSCALE = 0.08838834764831845f * 1.4426950408889634f;
constexpr float LAM0 = 0.2f;
constexpr int NWAVES = 8;
constexpr size_t MiB = 1u << 20;
constexpr size_t WS_CTL = 0, CTL_ZERO_BYTES = 1 * MiB;
constexpr size_t WS_SCR = 922 * MiB;
constexpr size_t WS_KC = 34 * MiB, WS_VC = WS_KC + 512 * 1024;
constexpr size_t WS_W1K = 35 * MiB, WS_W1V = 37 * MiB, WS_W2K = 39 * MiB, WS_W2V = WS_W2K + 65536;
constexpr size_t WS_WOUT = 40 * MiB, WS_WIN = 72 * MiB, WS_WGU1 = 162 * MiB, WS_WD1 = 334 * MiB, WS_WGU2 = 420 * MiB, WS_WD2 = 592 * MiB;
constexpr size_t WS_UB = 678 * MiB;
constexpr size_t WS_HID = 742 * MiB;
constexpr size_t WS_DPART = 986 * MiB;
constexpr size_t WS_END = 1114 * MiB;
constexpr int CW_DBG = 64;
constexpr int CW_QUEUE = 1024;
constexpr int CW_NORM = 16384;
constexpr int CW_DCNT = 65536;
constexpr int CW_RSS1 = 131072, CW_RSS2 = 139264;
constexpr int CW_BAR = 4096;
constexpr int RING_BYTES = 131072;
constexpr int AT_BUFSZ = 49152, AT_KSZ = 16384, AT_WS = 98304, AT_LIST = 100352, AT_GATE = 101440, AT_SELM = 104512, AT_UNI = 105536, AT_IMP = 105600, AT_SS = 138624, AT_ORD = 139648, AT_END = 140736;
constexpr int LDSCTL_OFF = 151552, MISC_OFF = LDSCTL_OFF + 320, LDS_BYTES = 155648;
static_assert(AT_END <= LDSCTL_OFF && MISC_OFF + 128 <= LDS_BYTES, "LDS map");

#define GAS __attribute__((address_space(1)))
#define LAS __attribute__((address_space(3)))
typedef unsigned short bf16;
typedef unsigned v4u __attribute__((ext_vector_type(4)));
typedef unsigned v2u __attribute__((ext_vector_type(2)));
typedef float f32x4 __attribute__((ext_vector_type(4)));
typedef float f32x16 __attribute__((ext_vector_type(16)));
typedef short bf16x8 __attribute__((ext_vector_type(8)));
typedef short s16x4 __attribute__((ext_vector_type(4)));
typedef GAS unsigned gu32;
#define RLX_AGENT __ATOMIC_RELAXED, __HIP_MEMORY_SCOPE_AGENT
#define LDS_WAIT() asm volatile("s_waitcnt lgkmcnt(0)" ::: "memory")
#define VM_WAIT() asm volatile("s_waitcnt vmcnt(0)" ::: "memory")
#define SBAR() __builtin_amdgcn_sched_barrier(0)
typedef float f32x2_t __attribute__((ext_vector_type(2))); typedef __bf16 bf16x2_t __attribute__((ext_vector_type(2)));
__device__ __forceinline__ unsigned cvtpk(float lo, float hi) { f32x2_t v = {lo, hi}; bf16x2_t b = __builtin_convertvector(v, bf16x2_t); return __builtin_bit_cast(unsigned, b); }
__device__ __forceinline__ float bf2f(unsigned short b) { return __uint_as_float(((unsigned)b) << 16); }
template <int K> __device__ __forceinline__ float swz_xor(float v) { return __int_as_float(__builtin_amdgcn_ds_swizzle(__float_as_int(v), (K << 10) | 0x1f)); }
__device__ __forceinline__ float dpp_xor1(float v) { return __int_as_float(__builtin_amdgcn_mov_dpp(__float_as_int(v), 0xB1, 0xF, 0xF, true)); }
__device__ __forceinline__ float wave_sum(float v) {
#pragma unroll
    for (int o = 1; o < 64; o <<= 1) v += __shfl_xor(v, o);
    return v;
}
#define XB_TMO      128
#define XB_XCNT(j)  (256  + 64 * (j))
#define XB_XSUB(j)  (1280 + 64 * (j))
#define XB_XGEN(j)  (2304 + 64 * (j))
#define XB_TOP      3328
#define XB_TOPGEN   3392
#define XCD_BAR_WORDS 3456
#define XB_SPIN_CAP (1u << 18)

__device__ __forceinline__ unsigned xb_ld(unsigned* p)              { return __hip_atomic_load(p, __ATOMIC_RELAXED, __HIP_MEMORY_SCOPE_AGENT); }
__device__ __forceinline__ unsigned xb_add(unsigned* p, unsigned v) { return __hip_atomic_fetch_add(p, v, __ATOMIC_RELAXED, __HIP_MEMORY_SCOPE_AGENT); }
__device__ __forceinline__ unsigned xb_xcc_id() { return (unsigned)__builtin_amdgcn_s_getreg((3 << 11) | 20) & 0xFu; }
#define XB_SPIN(cond, bar) do { unsigned _sp = 0; while (cond) { __builtin_amdgcn_s_sleep(1); \
    if ((++_sp & 255u) == 0u) { if (xb_ld(&(bar)[XB_TMO])) break; if (_sp > XB_SPIN_CAP) { atomicAdd(&(bar)[XB_TMO], 1u); break; } } } } while (0)

struct XcdBarrier {
    unsigned* bar; unsigned x;
    volatile LAS unsigned* st;
};

__device__ __forceinline__ XcdBarrier xcd_barrier_post(unsigned* bar, volatile LAS unsigned* st) {
    XcdBarrier b; b.bar = bar; b.x = xb_xcc_id(); b.st = st;
    if (threadIdx.x == 0) (void)xb_add(&bar[XB_XCNT(b.x)], 1u);
    return b;
}
__device__ __forceinline__ void xcd_barrier_complete(unsigned* bar, unsigned x, unsigned& nloc, unsigned& nx) {
    const unsigned G = gridDim.x * gridDim.y * gridDim.z;
    unsigned sum, cnt, mine, sp = 0u;
    for (;;) {
        sum = 0u; cnt = 0u; mine = 0u;
#pragma unroll
        for (unsigned j = 0; j < 16; ++j) { const unsigned c = xb_ld(&bar[XB_XCNT(j)]); sum += c; cnt += (c > 0u) ? 1u : 0u; mine = (j == x) ? c : mine; }
        if (sum == G) break;
        __builtin_amdgcn_s_sleep(1);
        if ((++sp & 255u) == 0u) { if (xb_ld(&bar[XB_TMO])) break; if (sp > XB_SPIN_CAP) { atomicAdd(&bar[XB_TMO], 1u); break; } }
    }
    nloc = mine > 0u ? mine : 1u; nx = cnt > 0u ? cnt : 1u;
}

__device__ __forceinline__ void xcd_barrier(const XcdBarrier& b) {
    asm volatile("s_waitcnt vmcnt(0)" ::: "memory");
    __syncthreads();
    if (threadIdx.x == 0) {
        unsigned* bar = b.bar;
        __builtin_amdgcn_s_waitcnt(0);
        unsigned nloc = b.st[0], nx = b.st[1];
        if (nloc == 0u) { xcd_barrier_complete(bar, b.x, nloc, nx); b.st[0] = nloc; b.st[1] = nx; }
        const unsigned old = xb_add(&bar[XB_XSUB(b.x)], 1u);
        const unsigned gen = old / nloc;
        if (old + 1u == (gen + 1u) * nloc) {
            __builtin_amdgcn_fence(__ATOMIC_RELEASE, "agent");
            asm volatile("s_waitcnt vmcnt(0)" ::: "memory");
            const unsigned og = xb_add(&bar[XB_TOP], 1u);
            const unsigned tg = og / nx;
            if (og + 1u == (tg + 1u) * nx) xb_add(&bar[XB_TOPGEN], 1u);
            else XB_SPIN(xb_ld(&bar[XB_TOPGEN]) == tg, bar);
            __builtin_amdgcn_fence(__ATOMIC_ACQUIRE, "agent");
            xb_add(&bar[XB_XGEN(b.x)], 1u);
            asm volatile("s_waitcnt vmcnt(0)" ::: "memory");
        } else {
            XB_SPIN(xb_ld(&bar[XB_XGEN(b.x)]) == gen, bar);
            __builtin_amdgcn_fence(__ATOMIC_ACQUIRE, "agent");
            asm volatile("s_waitcnt vmcnt(0)" ::: "memory");
        }
    }
    __syncthreads();
}
__device__ __forceinline__ int inv_perm32(int v) { return 16 * ((v >> 2) & 1) + 4 * (v >> 3) + (v & 3); }
__device__ __forceinline__ void tr_load(const float* __restrict__ W, int N, int item, int lane, f32x4 (&v)[16]) {
    const int nnb = (N + 63) >> 6, kb = item / nnb, nb = item - kb * nnb, k0 = kb * 64, n0 = nb * 64;
    const int c4 = (lane & 15) * 4, col = (n0 + c4 + 3 < N) ? n0 + c4 : 0;
    const float* p = W + (size_t)(k0 + (lane >> 4)) * N + col;
#pragma unroll
    for (int q = 0; q < 16; ++q) v[q] = *(const GAS f32x4*)(p + (size_t)(4 * q) * N);
}
__device__ __forceinline__ void tr_store(const f32x4 (&v)[16], int K, int N, bf16* WT, int mode, LAS float* scr, int item, int lane, int img) {
    const int nnb = (N + 63) >> 6, kb = item / nnb, nb = item - kb * nnb, k0 = kb * 64, n0 = nb * 64;
    { LAS float* w = scr + (lane >> 4) * 65 + (lane & 15) * 4;
#pragma unroll
      for (int q = 0; q < 16; ++q) { w[(4 * q) * 65 + 0] = v[q].x; w[(4 * q) * 65 + 1] = v[q].y; w[(4 * q) * 65 + 2] = v[q].z; w[(4 * q) * 65 + 3] = v[q].w; } }
    LDS_WAIT(); asm volatile("" ::: "memory");
    const int c = lane & 7;
    const int drow0 = (mode == 0) ? n0 : (256 * (n0 >> 7) + (n0 & 127) + (mode == 2 ? 128 : 0));
#pragma unroll
    for (int j = 0; j < 8; ++j) { const int nn = (lane >> 3) + 8 * j; const LAS float* s = scr + (8 * c) * 65 + nn;
        v4u o; o.x = cvtpk(s[0], s[65]); o.y = cvtpk(s[130], s[195]); o.z = cvtpk(s[260], s[325]); o.w = cvtpk(s[390], s[455]);
        if (n0 + nn < N) { const int drow = drow0 + nn;
            if (img == 0) *(GAS v4u*)(WT + (size_t)drow * K + k0 + 8 * c) = o;
            else { const int r128 = drow & 127, rho = (img == 2) ? ((r128 & ~31) + inv_perm32(r128 & 31)) : r128;
                   *(GAS v4u*)((char*)WT + ((size_t)(drow >> 7) * (K >> 6) + kb) * 16384 + pg8::lds_byte(rho, 8 * c)) = o; } } }
    LDS_WAIT(); asm volatile("" ::: "memory");
}
__device__ __forceinline__ void tr_range(const float* __restrict__ W, int K, int N, bf16* WT, int mode, LAS float* scr, int lo, int hi, int w, int nw, int lane, int img) {
    int it = lo + w;
    if (it >= hi) return;
    f32x4 va[16], vb[16];
    tr_load(W, N, it, lane, va);
    for (;;) {
        const int n1 = it + nw;
        if (n1 < hi) tr_load(W, N, n1, lane, vb);
        tr_store(va, K, N, WT, mode, scr, it, lane, img);
        if (n1 >= hi) break;
        const int n2 = n1 + nw;
        if (n2 < hi) tr_load(W, N, n2, lane, va);
        tr_store(vb, K, N, WT, mode, scr, n1, lane, img);
        if (n2 >= hi) break;
        it = n2;
    }
}
__device__ __forceinline__ void tr_matrix(const float* __restrict__ W, int K, int N, bf16* WT, int mode, LAS float* scr, int gw, int ngw, int lane, int img = 0) {
    tr_range(W, K, N, WT, mode, scr, 0, (K >> 6) * ((N + 63) >> 6), gw, ngw, lane, img);
}
__device__ __forceinline__ void tile_w1(const float* __restrict__ W1, bf16* W1f, int gw, int ngw, int lane) {
    const int r32 = lane & 31, hi = lane >> 5;
    for (int f = gw; f < 256 * 8; f += ngw) { const int step = f >> 3, cb = f & 7;
        const float* s = W1 + (size_t)(16 * step + 8 * hi) * 256 + 32 * cb + r32;
        v4u o; o.x = cvtpk(s[0], s[256]); o.y = cvtpk(s[512], s[768]); o.z = cvtpk(s[1024], s[1280]); o.w = cvtpk(s[1536], s[1792]);
        *(GAS v4u*)(W1f + ((size_t)f * 64 + lane) * 8) = o; }
}
__device__ __forceinline__ void rms_rows_bf16(const float* X, const float* __restrict__ g, bf16* O, int gw, int ngw, int lane) {
    for (int m = gw; m < SEQ; m += ngw) {
        const GAS f32x4* xr = (const GAS f32x4*)(X + (size_t)m * DM) + lane;
        f32x4 v[16]; float s = 0.f;
#pragma unroll
        for (int j = 0; j < 16; ++j) { v[j] = xr[64 * j]; s += (v[j].x * v[j].x + v[j].y * v[j].y) + (v[j].z * v[j].z + v[j].w * v[j].w); }
        const float rstd = 1.0f / sqrtf(wave_sum(s) * (1.0f / DM) + EPS);
        GAS v2u* o8 = (GAS v2u*)(O + (size_t)m * DM) + lane;
#pragma unroll
        for (int j = 0; j < 16; ++j) { const f32x4 gv = ((const f32x4*)g)[lane + 64 * j]; v2u w; w.x = cvtpk(v[j].x * rstd * gv.x, v[j].y * rstd * gv.y); w.y = cvtpk(v[j].z * rstd * gv.z, v[j].w * rstd * gv.w); o8[64 * j] = w; }
    }
}
__device__ __forceinline__ void rms_rows_f32(float* X, const float* __restrict__ g, int gw, int ngw, int lane) {
    for (int m = gw; m < SEQ; m += ngw) {
        GAS f32x4* xr = (GAS f32x4*)(X + (size_t)m * DM) + lane;
        f32x4 v[16]; float s = 0.f;
#pragma unroll
        for (int j = 0; j < 16; ++j) { v[j] = xr[64 * j]; s += (v[j].x * v[j].x + v[j].y * v[j].y) + (v[j].z * v[j].z + v[j].w * v[j].w); }
        const float rstd = 1.0f / sqrtf(wave_sum(s) * (1.0f / DM) + EPS);
#pragma unroll
        for (int j = 0; j < 16; ++j) { const f32x4 gv = ((const f32x4*)g)[lane + 64 * j]; xr[64 * j] = v[j] * rstd * gv; }
    }
}
__device__ __forceinline__ int crow(int r, int hi) { return (r & 3) + 8 * (r >> 2) + 4 * hi; }
__device__ __forceinline__ void compress_task(const bf16* proj, int off_kv, const float* __restrict__ pos, const bf16* __restrict__ W1t, const bf16* __restrict__ W2t, bf16* outc, int rb,
                                              char* shm, int wave, int lane) {
    const int r32 = lane & 31, hi = lane >> 5, tid = wave * 64 + lane;
    const int h = rb >> 4, c = ((rb & 15) << 5) + r32, ce = c < 511 ? c : 510;
    float* hsum = (float*)(shm + 32768);
    for (int i = tid; i < 32 * 256; i += 512) hsum[i] = 0.f;
    f32x16 acc[8];
#pragma unroll
    for (int cb = 0; cb < 8; ++cb) acc[cb] = f32x16{};
    const bf16* arow = PVEC(proj, off_kv + h * HD) + (size_t)(16 * ce + 4 * wave) * 128 + hi * 8;
    const float* prow = pos + (4 * wave) * HD + hi * 8;
    const bf16* bfrag = W1t + ((size_t)(32 * wave) * 8 * 64 + lane) * 8;
#pragma unroll 1
    for (int l = 0; l < 4; ++l) {
#pragma unroll 2
        for (int j = 0; j < 8; ++j) {
            const v4u av = *(const v4u*)(arow + (size_t)l * 128 + 16 * j);
            const f32x4 p0 = *(const f32x4*)(prow + l * HD + 16 * j), p1 = *(const f32x4*)(prow + l * HD + 16 * j + 4);
            bf16x8 bv[8];
#pragma unroll
            for (int cb = 0; cb < 8; ++cb) bv[cb] = *(const bf16x8*)(bfrag + (size_t)(((l * 8 + j) * 8 + cb) * 64) * 8);
            v4u aw;
            aw.x = cvtpk(__uint_as_float(av.x << 16) + p0.x, __uint_as_float(av.x & 0xffff0000u) + p0.y);
            aw.y = cvtpk(__uint_as_float(av.y << 16) + p0.z, __uint_as_float(av.y & 0xffff0000u) + p0.w);
            aw.z = cvtpk(__uint_as_float(av.z << 16) + p1.x, __uint_as_float(av.z & 0xffff0000u) + p1.y);
            aw.w = cvtpk(__uint_as_float(av.w << 16) + p1.z, __uint_as_float(av.w & 0xffff0000u) + p1.w);
            const bf16x8 af = __builtin_bit_cast(bf16x8, aw);
#pragma unroll
            for (int cb = 0; cb < 8; ++cb) acc[cb] = __builtin_amdgcn_mfma_f32_32x32x16_bf16(af, bv[cb], acc[cb], 0, 0, 0);
        }
    }
    __syncthreads();
#pragma unroll
    for (int cb = 0; cb < 8; ++cb)
#pragma unroll
        for (int r = 0; r < 16; ++r) atomicAdd((int*)hsum + crow(r, hi) * 256 + 32 * cb + r32, (int)rintf(acc[cb][r] * 65536.f));
    __syncthreads();
    bf16* hid = (bf16*)shm;
    for (int i = tid; i < 32 * 256; i += 512) { const float x = (float)((const int*)hsum)[i] * (1.0f / 65536.f); const float y = 1.5957691216057308f * (x + 0.044715f * x * x * x);
        const float gl = x * __builtin_amdgcn_rcpf(1.0f + __builtin_amdgcn_exp2f(-LOG2E * y));
        hid[(i >> 8) * 264 + (i & 255)] = (bf16)(cvtpk(gl, 0.f) & 0xffffu); }
    __syncthreads();
    if (wave < 4) {
        f32x16 a2 = {};
        const bf16* b2 = W2t + (size_t)(32 * wave + r32) * 256 + hi * 8;
#pragma unroll
        for (int kk = 0; kk < 16; ++kk) {
            const bf16x8 af = *(const bf16x8*)(hid + r32 * 264 + 16 * kk + hi * 8);
            const bf16x8 bv = *(const bf16x8*)(b2 + 16 * kk);
            a2 = __builtin_amdgcn_mfma_f32_32x32x16_bf16(af, bv, a2, 0, 0, 0);
        }
#pragma unroll
        for (int r = 0; r < 16; ++r) { const int cr = ((rb & 15) << 5) + crow(r, hi);
            outc[((size_t)h * 512 + cr) * HD + 32 * wave + r32] = (cr < 511) ? (bf16)(cvtpk(a2[r], 0.f) & 0xffffu) : (bf16)0; }
    }
    __syncthreads();
}
#define KSWZ(row, colB) ((row) * 256 + ((colB) ^ (((row) & 7) << 4)))
__device__ __forceinline__ int v_st(int k, int c) { const int kk = (k & ~0xC) | ((k & 4) << 1) | ((k & 8) >> 1); return ((kk >> 3) * 4 + (c >> 5)) * 512 + ((kk & 7) * 32 + (c & 31)) * 2; }
__device__ __forceinline__ int v_rd_base(int lane) { return ((lane & 3) << 3) | (((lane >> 2) & 3) << 6) | (((lane >> 4) & 1) << 5) | (((lane >> 5) & 1) << 8); }
constexpr int v_rd_off(int d0, int ks, int half) { return d0 * 512 + ks * 4096 + half * 2048; }
struct AttnP { const bf16* Kg; const bf16* Vg; int ldk; int ntiles; int tq; unsigned W; float sl2; float tref; };

__device__ __forceinline__ void qkt(f32x16& p0, f32x16& p1, const char* Kt, int r32, int hi, const bf16x8 (&qr)[8]) {
    const char* kb[4];
#pragma unroll
    for (int dd = 0; dd < 4; ++dd) kb[dd] = Kt + KSWZ(r32, (dd * 16 + hi * 8) * 2);
#pragma unroll
    for (int d0 = 0; d0 < 8; ++d0) { const char* a = kb[d0 & 3] + (d0 >> 2) * 128;
        const bf16x8 b0 = *reinterpret_cast<const bf16x8*>(a);
        const bf16x8 b1 = *reinterpret_cast<const bf16x8*>(a + 32 * 256);
        p0 = __builtin_amdgcn_mfma_f32_32x32x16_bf16(b0, qr[d0], p0, 0, 0, 0);
        p1 = __builtin_amdgcn_mfma_f32_32x32x16_bf16(b1, qr[d0], p1, 0, 0, 0); }
}
#define KRD_(dst, ad, off) asm volatile("ds_read_b128 %0, %1 offset:%2" : "=&v"(dst) : "v"(ad), "i"(off) : "memory")
#define KPAIR_(j) do { KRD_(b0[j], ka[(j) & 3], ((j) >> 2) * 128); KRD_(b1[j], ka[(j) & 3], ((j) >> 2) * 128 + 8192); } while (0)
#define KWAIT_(n) asm volatile("s_waitcnt lgkmcnt(%0)" :: "i"(n) : "memory")
template <int WIN>
__device__ __forceinline__ void qkt_pre(f32x16& p0, f32x16& p1, const char* Kt, int r32, int hi, const bf16x8 (&qr)[8]) {
    int ka[4];
#pragma unroll
    for (int dd = 0; dd < 4; ++dd) ka[dd] = (int)(unsigned)(uintptr_t)Kt + KSWZ(r32, (dd * 16 + hi * 8) * 2);
    bf16x8 b0[8], b1[8];
    KWAIT_(0); SBAR();
#define KSTEP_(j) do { if ((j) + WIN < 8) KPAIR_(((j) + WIN) & 7); \
        { constexpr int out_ = ((j) + WIN < 8 ? WIN : 7 - (j)) * 2; KWAIT_(out_); } SBAR(); \
        p0 = __builtin_amdgcn_mfma_f32_32x32x16_bf16(b0[j], qr[j], p0, 0, 0, 0); p1 = __builtin_amdgcn_mfma_f32_32x32x16_bf16(b1[j], qr[j], p1, 0, 0, 0); SBAR(); } while (0)
    KPAIR_(0); if (WIN > 1) KPAIR_(1); if (WIN > 2) KPAIR_(2); if (WIN > 3) KPAIR_(3); if (WIN > 4) KPAIR_(4); if (WIN > 5) KPAIR_(5); if (WIN > 6) KPAIR_(6); if (WIN > 7) KPAIR_(7);
    KSTEP_(0); KSTEP_(1); KSTEP_(2); KSTEP_(3); KSTEP_(4); KSTEP_(5); KSTEP_(6); KSTEP_(7);
#undef KSTEP_
}
__device__ __forceinline__ void pv_tile(f32x16 (&o)[4], int vb0, bf16x8 pa0, bf16x8 pa1, bf16x8 pa2, bf16x8 pa3) {
#define TRRD(dst, off) asm volatile("ds_read_b64_tr_b16 %0, %1 offset:%2" : "=&v"(dst) : "v"(vb0), "i"(off) : "memory")
#define PV_D0(d0) do { s16x4 l0, l1, l2, l3, h0, h1, h2, h3; constexpr int b_ = v_rd_off(d0, 0, 0); \
        TRRD(l0, b_); TRRD(h0, b_ + 2048); TRRD(l1, b_ + 4096); TRRD(h1, b_ + 6144); TRRD(l2, b_ + 8192); TRRD(h2, b_ + 10240); TRRD(l3, b_ + 12288); TRRD(h3, b_ + 14336); \
        asm volatile("s_waitcnt lgkmcnt(0)" ::: "memory"); SBAR(); \
        o[d0] = __builtin_amdgcn_mfma_f32_32x32x16_bf16(pa0, (bf16x8){l0[0], l0[1], l0[2], l0[3], h0[0], h0[1], h0[2], h0[3]}, o[d0], 0, 0, 0); \
        o[d0] = __builtin_amdgcn_mfma_f32_32x32x16_bf16(pa1, (bf16x8){l1[0], l1[1], l1[2], l1[3], h1[0], h1[1], h1[2], h1[3]}, o[d0], 0, 0, 0); \
        o[d0] = __builtin_amdgcn_mfma_f32_32x32x16_bf16(pa2, (bf16x8){l2[0], l2[1], l2[2], l2[3], h2[0], h2[1], h2[2], h2[3]}, o[d0], 0, 0, 0); \
        o[d0] = __builtin_amdgcn_mfma_f32_32x32x16_bf16(pa3, (bf16x8){l3[0], l3[1], l3[2], l3[3], h3[0], h3[1], h3[2], h3[3]}, o[d0], 0, 0, 0); } while (0)
    PV_D0(0); PV_D0(1); PV_D0(2); PV_D0(3);
#undef PV_D0
#undef TRRD
}
#define TRRD2(dst, off) asm volatile("ds_read_b64_tr_b16 %0, %1 offset:%2" : "=&v"(dst) : "v"(vb0), "i"(off) : "memory")
#define PVP_RD(S, g) do { constexpr int b_ = ((g) >> 2) * 16384 + ((g) & 3) * 512; TRRD2(S[0], b_); TRRD2(S[1], b_ + 2048); TRRD2(S[2], b_ + 4096); TRRD2(S[3], b_ + 6144); \
        TRRD2(S[4], b_ + 8192); TRRD2(S[5], b_ + 10240); TRRD2(S[6], b_ + 12288); TRRD2(S[7], b_ + 14336); } while (0)
#define PVP_MM(S, g) do { \
        o[g] = __builtin_amdgcn_mfma_f32_32x32x16_bf16(pa0, (bf16x8){S[0][0], S[0][1], S[0][2], S[0][3], S[1][0], S[1][1], S[1][2], S[1][3]}, o[g], 0, 0, 0); \
        o[g] = __builtin_amdgcn_mfma_f32_32x32x16_bf16(pa1, (bf16x8){S[2][0], S[2][1], S[2][2], S[2][3], S[3][0], S[3][1], S[3][2], S[3][3]}, o[g], 0, 0, 0); \
        o[g] = __builtin_amdgcn_mfma_f32_32x32x16_bf16(pa2, (bf16x8){S[4][0], S[4][1], S[4][2], S[4][3], S[5][0], S[5][1], S[5][2], S[5][3]}, o[g], 0, 0, 0); \
        o[g] = __builtin_amdgcn_mfma_f32_32x32x16_bf16(pa3, (bf16x8){S[6][0], S[6][1], S[6][2], S[6][3], S[7][0], S[7][1], S[7][2], S[7][3]}, o[g], 0, 0, 0); } while (0)
#define PVP_STEP(CUR, NXT, g, NG_) do { if ((g) + 1 < (NG_)) { PVP_RD(NXT, (g) + 1); asm volatile("s_waitcnt lgkmcnt(8)" ::: "memory"); } else { asm volatile("s_waitcnt lgkmcnt(0)" ::: "memory"); } SBAR(); PVP_MM(CUR, g); SBAR(); } while (0)
template <int NG>
__device__ __forceinline__ void pv_pipe(f32x16 (&o)[NG], int vb0, bf16x8 pa0, bf16x8 pa1, bf16x8 pa2, bf16x8 pa3) {
    s16x4 A[8], B[8];
    asm volatile("s_waitcnt lgkmcnt(0)" ::: "memory"); SBAR();
    PVP_RD(A, 0);
    PVP_STEP(A, B, 0, NG); PVP_STEP(B, A, 1, NG); PVP_STEP(A, B, 2, NG); PVP_STEP(B, A, 3, NG);
    if constexpr (NG == 8) { PVP_STEP(A, B, 4, NG); PVP_STEP(B, A, 5, NG); PVP_STEP(A, B, 6, NG); PVP_STEP(B, A, 7, NG); }
}
template <bool IMP, bool SEL, bool NOPV = false>
__device__ __forceinline__ void attn_run(char* shm, const AttnP a, const bf16x8 (&qr)[8], f32x16 (&o)[4], float& m_reg, float& l_reg, int vhalf,
                                         float inv_l, int impq) {
    int tid_ = threadIdx.x; asm volatile("" : "+v"(tid_));
    const int tid = tid_, wid = __builtin_amdgcn_readfirstlane(tid >> 6), lane = tid & 63, r32 = lane & 31, hi = lane >> 5;
    float* wsf = (float*)(shm + AT_WS) + wid * 64;
    int wbo_ = AT_WS + wid * 256 + 16 * hi; asm volatile("" : "+v"(wbo_)); const LAS float* wb = (const LAS float*)((LAS char*)shm + wbo_);
    const int* list = (const int*)(shm + AT_LIST);
    const int vb00 = (int)(unsigned)(uintptr_t)shm + AT_KSZ + v_rd_base(lane); (void)vhalf;
    unsigned koff[2], voff[2];
#pragma unroll
    for (int i2 = 0; i2 < 2; ++i2) { const int pk = wid * 2 + i2;
        const int row = 4 * pk + (lane >> 4), c = (lane & 15) ^ (row & 7); koff[i2] = (unsigned)(row * a.ldk + c * 8) * 2u;
        const int st = 2 * pk + (lane >> 5), pos = lane & 31, kk = (st >> 2) * 8 + (pos >> 2), k = (kk & ~0xC) | ((kk & 4) << 1) | ((kk & 8) >> 1), cv = (st & 3) * 32 + (pos & 3) * 8;
        voff[i2] = (unsigned)(k * a.ldk + cv) * 2u; }
    LAS unsigned char* lbase = (LAS unsigned char*)shm + wid * 2048;
#define DMA16(gp_, lp_) __builtin_amdgcn_global_load_lds((const unsigned*)(gp_), (LAS unsigned*)(lp_), 16, 0, 0)
#define STAGE(kb_, bo_) do { const char* kt_ = (const char*)(a.Kg + (size_t)(kb_) * a.ldk); const char* vt_ = (const char*)(a.Vg + (size_t)(kb_) * a.ldk); \
        DMA16(kt_ + koff[0], lbase + (bo_)); DMA16(kt_ + koff[1], lbase + (bo_) + 1024); \
        DMA16(vt_ + voff[0], lbase + (bo_) + AT_KSZ); DMA16(vt_ + voff[1], lbase + (bo_) + AT_KSZ + 1024); } while (0)
    int kb = __builtin_amdgcn_readfirstlane(list[0]);
    STAGE(kb, 0);
    int kbn = kb;
    if (a.ntiles > 1) { kbn = __builtin_amdgcn_readfirstlane(list[1]); STAGE(kbn, 32768); }
    VM_WAIT(); __syncthreads();
    int bo = 0;
    for (int i = 0; i < a.ntiles; ++i) {
        const bool more2 = i + 2 < a.ntiles;
        int kbn2 = kbn;
        if (more2) { kbn2 = __builtin_amdgcn_readfirstlane(list[i + 2]); const int b2 = bo >= 32768 ? bo - 32768 : bo + 65536; STAGE(kbn2, b2); }
        const int d0 = a.tq - kb;
        bool selok = true;
        if (SEL) { const int blk = kb >> 6; const unsigned w = ((const unsigned*)(shm + AT_SELM))[impq * 4 + (blk >> 5)]; selok = ((w >> (blk & 31)) & 1u) != 0u; }
        const bool anyv = selok && d0 >= 0 && (d0 - 63 < (int)a.W), full = selok && d0 >= 63 && (unsigned)d0 < a.W;
        if (__any(anyv)) {
        const bool unset = m_reg < -1e29f;
        const float ref = unset ? 0.f : m_reg;
        f32x16 p0, p1;
        { const float B0 = a.sl2 * ((float)(kb + 4 * hi) - a.tref) - ref;
#pragma unroll
          for (int r = 0; r < 16; ++r) { p0[r] = __builtin_fmaf(a.sl2, (float)((r & 3) + 8 * (r >> 2)), B0); p1[r] = __builtin_fmaf(a.sl2, (float)((r & 3) + 8 * (r >> 2) + 32), B0); } }
        qkt(p0, p1, shm + bo, r32, hi, qr);
        if (!__all(full)) {
            const int dq = selok ? d0 - 4 * hi : -1; const float NEG = -__builtin_inff();
#pragma unroll
            for (int r = 0; r < 16; ++r) { const int c = (r & 3) + 8 * (r >> 2);
                if ((unsigned)(dq - c) >= a.W) p0[r] = NEG;
                if ((unsigned)(dq - c - 32) >= a.W) p1[r] = NEG; } }
        float pmax = p0[0];
#pragma unroll
        for (int r = 1; r < 16; ++r) pmax = fmaxf(pmax, p0[r]);
#pragma unroll
        for (int r = 0; r < 16; ++r) pmax = fmaxf(pmax, p1[r]);
        { auto rr = __builtin_amdgcn_permlane32_swap(__float_as_uint(pmax), __float_as_uint(pmax), false, false); pmax = fmaxf(__uint_as_float(rr[0]), __uint_as_float(rr[1])); }
        const bool need = unset ? (pmax > -1e30f) : (pmax > 8.0f);
        if (__any(need)) {
            const float delta = need ? pmax : 0.f, alpha = (need && !unset) ? __builtin_amdgcn_exp2f(-pmax) : 1.0f;
            m_reg = need ? ref + pmax : m_reg;
#pragma unroll
            for (int r = 0; r < 16; ++r) { p0[r] -= delta; p1[r] -= delta; }
            l_reg *= alpha;
            if (__any(alpha < 1.f)) { if (hi == 0) wsf[r32] = alpha; LDS_WAIT();
#pragma unroll
                for (int r = 0; r < 16; ++r) { const float f = wb[(r & 3) + 8 * (r >> 2)];
#pragma unroll
                    for (int d = 0; d < 4; ++d) o[d][r] *= f; }
                LDS_WAIT(); }
        }
#pragma unroll
        for (int r = 0; r < 16; ++r) { p0[r] = __builtin_amdgcn_exp2f(p0[r]); p1[r] = __builtin_amdgcn_exp2f(p1[r]); }
        float ps = 0.f;
#pragma unroll
        for (int r = 0; r < 16; ++r) ps += p0[r] + p1[r];
        { auto rr = __builtin_amdgcn_permlane32_swap(__float_as_uint(ps), __float_as_uint(ps), false, false); ps = __uint_as_float(rr[0]) + __uint_as_float(rr[1]); }
        l_reg += ps;
        if (IMP) {
            float* imp = (float*)(shm + AT_IMP) + impq * 129 + (kb >> 2) + hi;
#pragma unroll
            for (int j = 0; j < 4; ++j) {
                const float a0 = ((p0[4 * j] + p0[4 * j + 1]) + (p0[4 * j + 2] + p0[4 * j + 3])) * inv_l, b0 = p0[4 * j + 3] * inv_l;
                const float a1 = ((p1[4 * j] + p1[4 * j + 1]) + (p1[4 * j + 2] + p1[4 * j + 3])) * inv_l, b1 = p1[4 * j + 3] * inv_l;
                const int n0 = (kb >> 2) + hi + 2 * j;
                unsigned* impu = (unsigned*)imp;
                atomicAdd(impu + 2 * j, (unsigned)(a0 * 16777216.f + 0.5f)); atomicAdd(impu + 2 * j + 1, (unsigned)(b0 * 16777216.f + 0.5f));
                atomicAdd(impu + 2 * j + 8, (unsigned)(a1 * 16777216.f + 0.5f)); if (n0 + 9 < 128) atomicAdd(impu + 2 * j + 9, (unsigned)(b1 * 16777216.f + 0.5f));
            }
        }
        bf16x8 pa0, pa1, pa2, pa3;
#define PK4(P, B_, OUT) do { unsigned a0_ = cvtpk(P[B_+0], P[B_+1]), a1_ = cvtpk(P[B_+2], P[B_+3]); unsigned b0_ = cvtpk(P[B_+4], P[B_+5]), b1_ = cvtpk(P[B_+6], P[B_+7]); \
        auto r0_ = __builtin_amdgcn_permlane32_swap(a0_, b0_, false, false); auto r1_ = __builtin_amdgcn_permlane32_swap(a1_, b1_, false, false); \
        v4u w_ = {r0_[0], r1_[0], r0_[1], r1_[1]}; OUT = __builtin_bit_cast(bf16x8, w_); } while (0)
        PK4(p0, 0, pa0); PK4(p0, 8, pa1); PK4(p1, 0, pa2); PK4(p1, 8, pa3);
#undef PK4
        SBAR();
        if (!NOPV) pv_pipe<4>(o, vb00 + bo, pa0, pa1, pa2, pa3);
        }
        if (more2) asm volatile("s_waitcnt vmcnt(4) lgkmcnt(0)" ::: "memory"); else asm volatile("s_waitcnt vmcnt(0) lgkmcnt(0)" ::: "memory");
        __builtin_amdgcn_s_barrier(); asm volatile("" ::: "memory");
        kb = kbn; kbn = kbn2; bo = bo >= 65536 ? 0 : bo + 32768;
    }
#undef STAGE
#undef DMA16
}
__device__ __forceinline__ const LAS float* lds_at(char* shm, int off) { asm volatile("" : "+v"(off)); return (const LAS float*)((LAS char*)shm + off); }
typedef GAS unsigned long long gu64;
constexpr int DJ_K = 0, DJ_V = 49152, DJ_P = 114688, DJ_AL = 147456;
static_assert(DJ_AL + 2048 <= LDSCTL_OFF, "diff job LDS map");
__device__ __forceinline__ void diff_job(const bf16* proj, bf16* mix, float* dpart, unsigned* dcnt, const float* __restrict__ dnorm, float lam, int h, int qt, int map, int jlo, char* shm,
                                         volatile LAS unsigned* qw, const int hot = 0) {
    int tid_ = threadIdx.x; asm volatile("" : "+v"(tid_));
    const int tid = tid_, wid = __builtin_amdgcn_readfirstlane(tid >> 6), lane = tid & 63, r32 = lane & 31, hi = lane >> 5;
    const bool prod = wid < 4;
    const int rg = wid & 3, t0 = 128 * qt, t = t0 + 32 * rg + r32, ntiles = 2 * (qt + 1) - jlo;
    const float sl2 = __builtin_amdgcn_exp2f(-(float)(h + 1)) * LOG2E, tref = (float)t0;
    const bf16* Kg = PVEC(proj, OFF_DK + h * 256 + map * 128); const bf16* Vg = PVEC(proj, OFF_DV + h * 256);
    unsigned koff[2], voff[2];
#pragma unroll
    for (int i2 = 0; i2 < 2; ++i2) { const int pk = wid * 2 + i2;
        const int row = 4 * pk + (lane >> 4), c = (lane & 15) ^ (row & 7); koff[i2] = (unsigned)(row * 128 + c * 8) * 2u;
        const int st = 2 * pk + (lane >> 5), pos = lane & 31, kk = (st >> 2) * 8 + (pos >> 2), k = (kk & ~0xC) | ((kk & 4) << 1) | ((kk & 8) >> 1), cv = (st & 3) * 32 + (pos & 3) * 8;
        voff[i2] = (unsigned)(k * 128 + cv) * 2u; }
    LAS unsigned char* lbase = (LAS unsigned char*)shm + wid * 2048;
#define DMA16(gp_, lp_) __builtin_amdgcn_global_load_lds((const unsigned*)(gp_), (LAS unsigned*)(lp_), 16, 0, 0)
#define STAGE_KX(kb_, so_, K0_, K1_, LB_) do { const char* kt_ = (const char*)(Kg + (size_t)(kb_) * 128); DMA16(kt_ + (K0_), (LB_) + DJ_K + (so_)); DMA16(kt_ + (K1_), (LB_) + DJ_K + (so_) + 1024); } while (0)
#define STAGE_VX(kb_, so_, V0_, V1_, LB_) do { const char* vt_ = (const char*)(Vg + (size_t)(kb_) * 128); const char* vt2_ = vt_ + (size_t)SEQ * 256; DMA16(vt_ + (V0_), (LB_) + DJ_V + (so_)); DMA16(vt_ + (V1_), (LB_) + DJ_V + (so_) + 1024); \
        DMA16(vt2_ + (V0_), (LB_) + DJ_V + (so_) + 16384); DMA16(vt2_ + (V1_), (LB_) + DJ_V + (so_) + 16384 + 1024); } while (0)
#define STAGE_K(kb_, so_) STAGE_KX(kb_, so_, koff[0], koff[1], lbase)
#define STAGE_V(kb_, so_) STAGE_VX(kb_, so_, voff[0], voff[1], lbase)
    float* alb = (float*)(shm + DJ_AL);
    int wbo_ = DJ_AL + rg * 128 + 16 * hi; asm volatile("" : "+v"(wbo_)); const LAS float* wb = (const LAS float*)((LAS char*)shm + wbo_);
    const int vb00 = (int)(unsigned)(uintptr_t)shm + DJ_V + v_rd_base(lane);
    f32x16 o[8];
    STAGE_K(64 * jlo, 0); if (ntiles > 1) STAGE_K(64 * jlo + 64, AT_KSZ); VM_WAIT(); __syncthreads();
    if (prod) {
        unsigned koffB[2], voffB[2];
#pragma unroll
        for (int i2 = 0; i2 < 2; ++i2) { const int pk = (wid + 4) * 2 + i2;
            const int row = 4 * pk + (lane >> 4), c = (lane & 15) ^ (row & 7); koffB[i2] = (unsigned)(row * 128 + c * 8) * 2u;
            const int st = 2 * pk + (lane >> 5), pos = lane & 31, kk = (st >> 2) * 8 + (pos >> 2), k = (kk & ~0xC) | ((kk & 4) << 1) | ((kk & 8) >> 1), cv = (st & 3) * 32 + (pos & 3) * 8;
            voffB[i2] = (unsigned)(k * 128 + cv) * 2u; }
        LAS unsigned char* lbaseB = (LAS unsigned char*)shm + (wid + 4) * 2048;
        bf16x8 qr[8];
        { const bf16* qrow = PVEC(proj, OFF_DQ + h * 256 + map * 128) + (size_t)t * 128 + hi * 8;
#pragma unroll
          for (int d0 = 0; d0 < 8; ++d0) qr[d0] = *(const bf16x8*)(qrow + d0 * 16); }
        float m_reg = -1e30f, l_reg = 0.f;
        f32x16 pA0, pA1, pB0, pB1; float rfA = 0.f, rfB = 0.f;
#define DJ_QK(P0, P1, RF, ii) do { const int kb_ = 64 * (jlo + (ii)); RF = (m_reg < -1e29f) ? 0.f : m_reg; const float B0_ = sl2 * ((float)(kb_ + 4 * hi) - tref) - RF; \
            _Pragma("unroll") for (int r = 0; r < 16; ++r) { P0[r] = __builtin_fmaf(sl2, (float)((r & 3) + 8 * (r >> 2)), B0_); P1[r] = __builtin_fmaf(sl2, (float)((r & 3) + 8 * (r >> 2) + 32), B0_); } \
            if (hot != 5) qkt_pre<8>(P0, P1, shm + DJ_K + ((ii) % 3) * AT_KSZ, r32, hi, qr); } while (0)
#define DJ_SM(P0, P1, RF, ii) do { if (hot == 6) { asm volatile("" : "+v"(P0), "+v"(P1)); break; } const int kb_ = 64 * (jlo + (ii)); const int d0_ = t - kb_; \
            if (!__all(d0_ >= 63)) { const int dq_ = d0_ - 4 * hi; const float NEG_ = -__builtin_inff(); \
                _Pragma("unroll") for (int r = 0; r < 16; ++r) { const int c_ = (r & 3) + 8 * (r >> 2); if (dq_ - c_ < 0) P0[r] = NEG_; if (dq_ - c_ - 32 < 0) P1[r] = NEG_; } } \
            const bool unset_ = m_reg < -1e29f; const float ref_ = unset_ ? 0.f : m_reg; const float adj_ = ref_ - RF;     \
            float pmax_ = P0[0]; \
            _Pragma("unroll") for (int r = 1; r < 16; ++r) pmax_ = fmaxf(pmax_, P0[r]); \
            _Pragma("unroll") for (int r = 0; r < 16; ++r) pmax_ = fmaxf(pmax_, P1[r]); \
            { auto rr_ = __builtin_amdgcn_permlane32_swap(__float_as_uint(pmax_), __float_as_uint(pmax_), false, false); pmax_ = fmaxf(__uint_as_float(rr_[0]), __uint_as_float(rr_[1])); } \
            pmax_ -= adj_; \
            const bool need_ = unset_ ? (pmax_ > -1e30f) : (pmax_ > 8.0f); \
            float alpha_ = 1.0f; float sub_ = adj_; \
            if (__any(need_)) { alpha_ = (need_ && !unset_) ? __builtin_amdgcn_exp2f(-pmax_) : 1.0f; m_reg = need_ ? ref_ + pmax_ : m_reg; sub_ += need_ ? pmax_ : 0.f; l_reg *= alpha_; } \
            if (__any(sub_ != 0.f)) { _Pragma("unroll") for (int r = 0; r < 16; ++r) { P0[r] -= sub_; P1[r] -= sub_; } } \
            _Pragma("unroll") for (int r = 0; r < 16; ++r) { P0[r] = __builtin_amdgcn_exp2f(P0[r]); P1[r] = __builtin_amdgcn_exp2f(P1[r]); } \
            float ps_ = 0.f; \
            _Pragma("unroll") for (int r = 0; r < 16; ++r) ps_ += P0[r] + P1[r]; \
            { auto rr_ = __builtin_amdgcn_permlane32_swap(__float_as_uint(ps_), __float_as_uint(ps_), false, false); ps_ = __uint_as_float(rr_[0]) + __uint_as_float(rr_[1]); } \
            l_reg += ps_; \
            bf16x8 pa0_, pa1_, pa2_, pa3_; \
            DJ_PK4(P0, 0, pa0_); DJ_PK4(P0, 8, pa1_); DJ_PK4(P1, 0, pa2_); DJ_PK4(P1, 8, pa3_); \
            bf16x8* pb_ = (bf16x8*)(shm + DJ_P + ((ii) & 1) * 16384 + rg * 4096) + lane; \
            pb_[0] = pa0_; pb_[64] = pa1_; pb_[128] = pa2_; pb_[192] = pa3_; \
            if (hi == 0) alb[((ii) & 1) * 128 + rg * 32 + r32] = alpha_; } while (0)
#define DJ_PK4(P, B_, OUT) do { unsigned a0_ = cvtpk(P[B_+0], P[B_+1]), a1_ = cvtpk(P[B_+2], P[B_+3]); unsigned b0_ = cvtpk(P[B_+4], P[B_+5]), b1_ = cvtpk(P[B_+6], P[B_+7]); \
            auto r0_ = __builtin_amdgcn_permlane32_swap(a0_, b0_, false, false); auto r1_ = __builtin_amdgcn_permlane32_swap(a1_, b1_, false, false); \
            v4u w_ = {r0_[0], r1_[0], r0_[1], r1_[1]}; OUT = __builtin_bit_cast(bf16x8, w_); } while (0)
#define DJ_STAGE(ii) do { if (hot < 2) { if ((ii) + 2 < ntiles) { STAGE_K(64 * (jlo + (ii) + 2), (((ii) + 2) % 3) * AT_KSZ); STAGE_KX(64 * (jlo + (ii) + 2), (((ii) + 2) % 3) * AT_KSZ, koffB[0], koffB[1], lbaseB); } \
            if ((ii) < ntiles) { STAGE_V(64 * (jlo + (ii)), ((ii) & 1) * 32768); STAGE_VX(64 * (jlo + (ii)), ((ii) & 1) * 32768, voffB[0], voffB[1], lbaseB); } } } while (0)
        DJ_QK(pA0, pA1, rfA, 0);
        int i = 0;
        for (; i + 1 < ntiles; i += 2) {
            DJ_STAGE(i);     DJ_QK(pB0, pB1, rfB, i + 1);                         DJ_SM(pA0, pA1, rfA, i);     VM_WAIT(); __syncthreads();
            DJ_STAGE(i + 1); if (i + 2 < ntiles) DJ_QK(pA0, pA1, rfA, i + 2);     DJ_SM(pB0, pB1, rfB, i + 1); VM_WAIT(); __syncthreads();
        }
        if (i < ntiles) { DJ_STAGE(i); DJ_SM(pA0, pA1, rfA, i); VM_WAIT(); __syncthreads(); ++i; }
        DJ_STAGE(i); VM_WAIT(); __syncthreads();
#undef DJ_QK
#undef DJ_SM
#undef DJ_PK4
        if (hi == 0) alb[256 + rg * 32 + r32] = l_reg;
    } else {
#pragma unroll
        for (int d = 0; d < 8; ++d) o[d] = f32x16{};
        for (int i = 0; i <= ntiles; ++i) {
            const int kb = 64 * (jlo + i);
            if (i >= 1 && hot != 3) {
                const int sl = (i - 1) & 1;
                { bool any = false; float f[16];
#pragma unroll
                  for (int r = 0; r < 16; ++r) { f[r] = wb[sl * 128 + (r & 3) + 8 * (r >> 2)]; any |= f[r] < 1.f; }
                  if (__any(any)) {
#pragma unroll
                      for (int r = 0; r < 16; ++r)
#pragma unroll
                          for (int d = 0; d < 8; ++d) o[d][r] *= f[r]; } }
                const bf16x8* pb = (const bf16x8*)(shm + DJ_P + sl * 16384 + rg * 4096) + lane;
                bf16x8 pa0 = pb[0], pa1 = pb[64], pa2 = pb[128], pa3 = pb[192];
                asm volatile("" : "+v"(pa0), "+v"(pa1), "+v"(pa2), "+v"(pa3));
                pv_pipe<8>(o, vb00 + sl * 32768, pa0, pa1, pa2, pa3);
            }
            VM_WAIT();
            __syncthreads();
        }
    }
#undef DJ_STAGE
#undef STAGE_KX
#undef STAGE_VX
#undef STAGE_K
#undef STAGE_V
#undef DMA16
    __syncthreads();
    const int pair = h * 64 + qt, ctid = tid - 256;
    if (hot) { __syncthreads(); return; }
    if (!prod) {
#pragma unroll
        for (int r = 0; r < 16; ++r) { const float rl = __builtin_amdgcn_rcpf(wb[256 + (r & 3) + 8 * (r >> 2)]);
#pragma unroll
            for (int d = 0; d < 8; ++d) o[d][r] *= rl; }
        const char* mine = (const char*)(dpart + (size_t)(pair * 2 + map) * 32768);
#pragma unroll
        for (int d = 0; d < 8; ++d)
#pragma unroll
            for (int r4 = 0; r4 < 4; ++r4) { gu64* p = (gu64*)(mine + (d * 4 + r4) * 2048) + ctid;
                const unsigned lo = cvtpk(o[d][4 * r4], o[d][4 * r4 + 1]), hi2 = cvtpk(o[d][4 * r4 + 2], o[d][4 * r4 + 3]);
                __hip_atomic_store(p, ((unsigned long long)hi2 << 32) | lo, RLX_AGENT);
                o[d][4 * r4] = __uint_as_float(lo << 16); o[d][4 * r4 + 1] = __uint_as_float(lo & 0xffff0000u); o[d][4 * r4 + 2] = __uint_as_float(hi2 << 16); o[d][4 * r4 + 3] = __uint_as_float(hi2 & 0xffff0000u); }
    }
    asm volatile("s_waitcnt vmcnt(0)" ::: "memory");
    __syncthreads();
    if (tid == 0) qw[1] = __hip_atomic_fetch_add(dcnt + 64 * pair, 1u, __ATOMIC_RELAXED, __HIP_MEMORY_SCOPE_AGENT);
    __syncthreads();
    const unsigned old = (unsigned)__builtin_amdgcn_readfirstlane((int)qw[1]);
    __syncthreads();
    if (old == 0u) return;
    if (!prod) {
        const char* theirs = (const char*)(dpart + (size_t)(pair * 2 + (map ^ 1)) * 32768);
#pragma unroll
        for (int d = 0; d < 8; ++d) {
#pragma unroll
            for (int r4 = 0; r4 < 4; ++r4) { gu64* p = (gu64*)(theirs + (d * 4 + r4) * 2048) + ctid;
                const unsigned long long w = __hip_atomic_load(p, RLX_AGENT); const unsigned lo = (unsigned)w, hi2 = (unsigned)(w >> 32);
                const float p0 = __uint_as_float(lo << 16), p1 = __uint_as_float(lo & 0xffff0000u), p2 = __uint_as_float(hi2 << 16), p3 = __uint_as_float(hi2 & 0xffff0000u);
                const float a0 = o[d][4 * r4], a1 = o[d][4 * r4 + 1], a2 = o[d][4 * r4 + 2], a3 = o[d][4 * r4 + 3];
                o[d][4 * r4] = map ? (p0 - lam * a0) : (a0 - lam * p0); o[d][4 * r4 + 1] = map ? (p1 - lam * a1) : (a1 - lam * p1);
                o[d][4 * r4 + 2] = map ? (p2 - lam * a2) : (a2 - lam * p2); o[d][4 * r4 + 3] = map ? (p3 - lam * a3) : (a3 - lam * p3); }
            asm volatile("" : "+v"(o[d]) :: "memory"); }
        float gn[8];
#pragma unroll
        for (int d = 0; d < 8; ++d) gn[d] = dnorm[32 * d + r32] * (1.0f - LAM0);
#pragma unroll
        for (int r = 0; r < 16; ++r) { float s = 0.f;
#pragma unroll
            for (int d = 0; d < 8; ++d) s += o[d][r] * o[d][r];
            s += swz_xor<1>(s); s += swz_xor<2>(s); s += swz_xor<4>(s); s += swz_xor<8>(s); s += swz_xor<16>(s);
            const float sc = 1.0f / sqrtf(s * (1.0f / 256.0f) + EPS);
            bf16* orow = mix + (size_t)(t0 + 32 * rg + crow(r, hi)) * DM + h * 256 + r32;
#pragma unroll
            for (int d = 0; d < 8; ++d) { const float v = o[d][r] * sc * gn[d]; const float vn = dpp_xor1(v);
                if ((r32 & 1) == 0) *(unsigned*)(orow + 32 * d) = cvtpk(v, vn); } }
    }
    __syncthreads();
}
__device__ __forceinline__ void norm_pass(const bf16* proj, float* slots, int bx, int G, char* shm) {
    const int tid = threadIdx.x, wave = tid >> 6, ln = tid & 63, v = ln >> 1, half = ln & 1;
    float mx = 0.f;
    for (int t = bx * NWAVES + wave; t < SEQ; t += G * NWAVES) {
        const v4u* p = (const v4u*)(PVEC(proj, v * 128) + (size_t)t * 128 + half * 64);
        float s = 0.f;
#pragma unroll
        for (int i = 0; i < 8; ++i) { const v4u w = p[i];
            const float a0 = __uint_as_float(w.x << 16), a1 = __uint_as_float(w.x & 0xffff0000u), a2 = __uint_as_float(w.y << 16), a3 = __uint_as_float(w.y & 0xffff0000u);
            const float a4 = __uint_as_float(w.z << 16), a5 = __uint_as_float(w.z & 0xffff0000u), a6 = __uint_as_float(w.w << 16), a7 = __uint_as_float(w.w & 0xffff0000u);
            s += (a0 * a0 + a1 * a1) + (a2 * a2 + a3 * a3) + (a4 * a4 + a5 * a5) + (a6 * a6 + a7 * a7); }
        s += dpp_xor1(s);
        mx = fmaxf(mx, s);
    }
    float* red = (float*)shm;
    if (half == 0) red[wave * 32 + v] = mx;
    __syncthreads();
    if (tid < 32) { float m = red[tid];
#pragma unroll
        for (int w = 1; w < NWAVES; ++w) m = fmaxf(m, red[w * 32 + tid]);
        slots[bx * 32 + tid] = sqrtf(m) * 1.004f; }
    __syncthreads();
}
__device__ __forceinline__ void nsa_unit(const bf16* proj, const bf16* kc, const bf16* vc, bf16* mix, float* scr, const float* __restrict__ gate_bias, int hkv, int qt, char* shm, const int probe = 0) {
    int tid_ = threadIdx.x; asm volatile("" : "+v"(tid_));
    const int tid = tid_, wid = __builtin_amdgcn_readfirstlane(tid >> 6), lane = tid & 63, r32 = lane & 31, hi = lane >> 5;
    const int g = wid & 3, qs = wid >> 2, t0 = 64 * qt, q = 32 * qs + r32, t = t0 + q, head = hkv * 4 + g;
    int* list = (int*)(shm + AT_LIST);
    float* wsf = (float*)(shm + AT_WS) + wid * 64;
    float* gates = (float*)(shm + AT_GATE);
    float* imp = (float*)(shm + AT_IMP);
    unsigned* uni = (unsigned*)(shm + AT_UNI);
    unsigned short* selm16 = (unsigned short*)(shm + AT_SELM);
    const float slope = __builtin_amdgcn_exp2f(-0.5f * (float)(head + 1));
    for (int i = tid; i < 64 * 129; i += 512) imp[i] = 0.f;
    if (tid < 8) uni[tid] = 0u;
    for (int i = tid; i < 768; i += 512) { const int qq = i / 12, rem = i - qq * 12;
        const float v = bf2f(PVEC(proj, OFF_G)[(size_t)(t0 + qq) * 128 + hkv * 12 + rem]) + gate_bias[hkv * 12 + rem];
        gates[i] = __builtin_amdgcn_rcpf(1.0f + __builtin_amdgcn_exp2f(-LOG2E * v)); }
    const int ntc = ((t0 + 32) >> 10) + 1;
    if (tid < ntc) list[tid] = 64 * tid;
    __syncthreads();
    bf16x8 qr[8];
    { const bf16* qrow = PVEC(proj, OFF_NQ + head * 128) + (size_t)t * 128 + hi * 8;
#pragma unroll
      for (int d0 = 0; d0 < 8; ++d0) qr[d0] = *(const bf16x8*)(qrow + d0 * 16); }
    f32x16 o[4];
    float rf[16];
    const LAS float* wb = lds_at(shm, AT_WS + wid * 256 + 16 * hi);
    const LAS float* gb = lds_at(shm, AT_GATE + ((32 * qs + 4 * hi) * 12 + g * 3) * 4);
    {
        AttnP a; a.Kg = kc + (size_t)hkv * 512 * HD; a.Vg = vc + (size_t)hkv * 512 * HD; a.ldk = HD; a.ntiles = ntc; a.tq = (t >= 31) ? ((t - 31) >> 4) : -1; a.W = 0x7fffffffu;
        a.sl2 = 16.0f * slope * LOG2E; a.tref = ((float)t0 - 31.0f) * (1.0f / 16.0f);
#pragma unroll
        for (int d = 0; d < 4; ++d) o[d] = f32x16{};
        float m_reg = -1e30f, l_reg = 0.f;
        if (!(probe & 1)) attn_run<false, false, true>(shm, a, qr, o, m_reg, l_reg, 0, 0.f, 0);
        const float inv_l = l_reg > 0.f ? 1.0f / l_reg : 0.f;
#pragma unroll
        for (int d = 0; d < 4; ++d) o[d] = f32x16{};
        float l2 = 0.f;
        if (!(probe & 2)) { if (probe & 32) attn_run<false, false>(shm, a, qr, o, m_reg, l2, 0, inv_l, q); else attn_run<true, false>(shm, a, qr, o, m_reg, l2, 0, inv_l, q); }
        if (hi == 0) wsf[r32] = inv_l; LDS_WAIT();
#pragma unroll
        for (int r = 0; r < 16; ++r) rf[r] = wb[(r & 3) + 8 * (r >> 2)] * gb[12 * ((r & 3) + 8 * (r >> 2)) + 0];
        LDS_WAIT();
#pragma unroll
        for (int d = 0; d < 4; ++d)
#pragma unroll
            for (int c2 = 0; c2 < 2; ++c2) { v4u w;
                w.x = cvtpk(o[d][8 * c2 + 0] * rf[8 * c2 + 0], o[d][8 * c2 + 1] * rf[8 * c2 + 1]); w.y = cvtpk(o[d][8 * c2 + 2] * rf[8 * c2 + 2], o[d][8 * c2 + 3] * rf[8 * c2 + 3]);
                w.z = cvtpk(o[d][8 * c2 + 4] * rf[8 * c2 + 4], o[d][8 * c2 + 5] * rf[8 * c2 + 5]); w.w = cvtpk(o[d][8 * c2 + 6] * rf[8 * c2 + 6], o[d][8 * c2 + 7] * rf[8 * c2 + 7]);
                ((GAS v4u*)scr)[(d * 2 + c2) * 512 + tid] = w; }
    }
    {
        const int qq = tid >> 3, part = tid & 7;
        float s[16];
#pragma unroll
        for (int e = 0; e < 16; ++e) { const int n = part * 16 + e; const float v = (float)((const unsigned*)imp)[qq * 129 + n] * (1.0f / 16777216.f);
            s[e] = (n == 0 || n == qt || n == qt - 1) ? 1e4f : (n <= qt ? v : -1.0f); }
        __syncthreads();
#pragma unroll
        for (int e = 0; e < 16; ++e) imp[qq * 129 + part * 16 + e] = s[e];
        __syncthreads();
        unsigned bits = 0u;
        if (qt < 16) { if (part == 0) bits = (2u << qt) - 1u; }
        else {
            unsigned key[16];
#pragma unroll
            for (int e = 0; e < 16; ++e) key[e] = s[e] < 0.f ? 0u : __float_as_uint(s[e]) + 1u;
            unsigned T = 0u;
#pragma unroll 1
            for (int bit = 31; bit >= 0; --bit) { const unsigned c = T | (1u << bit); int cnt = 0;
#pragma unroll
                for (int e = 0; e < 16; ++e) cnt += key[e] >= c ? 1 : 0;
                cnt += __builtin_amdgcn_mov_dpp(cnt, 0xB1, 0xF, 0xF, true); cnt += __builtin_amdgcn_mov_dpp(cnt, 0x4E, 0xF, 0xF, true);
                cnt += __builtin_amdgcn_ds_swizzle(cnt, (4 << 10) | 0x1f);
                if (cnt >= 16) T = c; }
            int cgt = 0, ceq = 0;
#pragma unroll
            for (int e = 0; e < 16; ++e) { cgt += key[e] > T ? 1 : 0; ceq += key[e] == T ? 1 : 0; }
            cgt += __builtin_amdgcn_mov_dpp(cgt, 0xB1, 0xF, 0xF, true); cgt += __builtin_amdgcn_mov_dpp(cgt, 0x4E, 0xF, 0xF, true); cgt += __builtin_amdgcn_ds_swizzle(cgt, (4 << 10) | 0x1f);
            int pre = ceq;
            { const int l8 = tid & 7; int t1 = __shfl_up(pre, 1, 8); if (l8 >= 1) pre += t1; int t2 = __shfl_up(pre, 2, 8); if (l8 >= 2) pre += t2; int t4 = __shfl_up(pre, 4, 8); if (l8 >= 4) pre += t4; }
            int run = pre - ceq; const int need = 16 - cgt;
#pragma unroll
            for (int e = 0; e < 16; ++e) { const bool eq = key[e] == T; if (key[e] > T || (eq && run < need)) bits |= 1u << e; run += eq ? 1 : 0; }
        }
        selm16[qq * 8 + part] = (unsigned short)bits;
        if (bits) atomicOr(&uni[part >> 1], bits << (16 * (part & 1)));
        __syncthreads();
        if (tid < 128) {
            const unsigned u0 = uni[0], u1 = uni[1], u2 = uni[2], u3 = uni[3]; const int w = tid >> 5, b = tid & 31;
            const unsigned uw = w == 0 ? u0 : (w == 1 ? u1 : (w == 2 ? u2 : u3));
            if ((uw >> b) & 1u) { int pos = __popc(uw & ((1u << b) - 1u)); if (w > 0) pos += __popc(u0); if (w > 1) pos += __popc(u1); if (w > 2) pos += __popc(u2); list[pos] = 64 * tid; }
            if (tid == 0) uni[4] = (unsigned)(__popc(u0) + __popc(u1) + __popc(u2) + __popc(u3)); }
        __syncthreads();
    }
    {
        AttnP a; a.Kg = PVEC(proj, OFF_KS + hkv * HD); a.Vg = PVEC(proj, OFF_VS + hkv * HD); a.ldk = 128; a.ntiles = (int)uni[4]; a.tq = t; a.W = 0x7fffffffu; a.sl2 = slope * LOG2E; a.tref = (float)t0;
#pragma unroll
        for (int d = 0; d < 4; ++d) o[d] = f32x16{};
        float m_reg = -1e30f, l_reg = 0.f;
        if (!(probe & 4)) attn_run<false, true>(shm, a, qr, o, m_reg, l_reg, 0, 0.f, q);
        if (hi == 0) wsf[r32] = l_reg; LDS_WAIT();
#pragma unroll
        for (int r = 0; r < 16; ++r) rf[r] = __builtin_amdgcn_rcpf(wb[(r & 3) + 8 * (r >> 2)]) * gb[12 * ((r & 3) + 8 * (r >> 2)) + 1];
        LDS_WAIT();
#define BFLO(u_) __uint_as_float((u_) << 16)
#define BFHI(u_) __uint_as_float((u_) & 0xffff0000u)
#pragma unroll
        for (int d = 0; d < 4; ++d)
#pragma unroll
            for (int c2 = 0; c2 < 2; ++c2) { GAS v4u* p = (GAS v4u*)scr + (d * 2 + c2) * 512 + tid; const v4u t4 = *p; v4u w;
                w.x = cvtpk(BFLO(t4.x) + o[d][8 * c2 + 0] * rf[8 * c2 + 0], BFHI(t4.x) + o[d][8 * c2 + 1] * rf[8 * c2 + 1]); w.y = cvtpk(BFLO(t4.y) + o[d][8 * c2 + 2] * rf[8 * c2 + 2], BFHI(t4.y) + o[d][8 * c2 + 3] * rf[8 * c2 + 3]);
                w.z = cvtpk(BFLO(t4.z) + o[d][8 * c2 + 4] * rf[8 * c2 + 4], BFHI(t4.z) + o[d][8 * c2 + 5] * rf[8 * c2 + 5]); w.w = cvtpk(BFLO(t4.w) + o[d][8 * c2 + 6] * rf[8 * c2 + 6], BFHI(t4.w) + o[d][8 * c2 + 7] * rf[8 * c2 + 7]);
                *p = w; }
    }
    {
        const int jlo = qt >= 8 ? qt - 8 : 0, nw = qt - jlo + 1;
        if (tid < nw) list[tid] = 64 * (jlo + tid);
        __syncthreads();
        AttnP a; a.Kg = PVEC(proj, OFF_KW + hkv * HD); a.Vg = PVEC(proj, OFF_VW + hkv * HD); a.ldk = 128; a.ntiles = nw; a.tq = t; a.W = 512u; a.sl2 = slope * LOG2E; a.tref = (float)t0;
#pragma unroll
        for (int d = 0; d < 4; ++d) o[d] = f32x16{};
        float m_reg = -1e30f, l_reg = 0.f;
        if (!(probe & 8)) attn_run<false, false>(shm, a, qr, o, m_reg, l_reg, 0, 0.f, 0);
        if (probe) { __syncthreads(); return; }
        if (hi == 0) wsf[r32] = l_reg; LDS_WAIT();
#pragma unroll
        for (int r = 0; r < 16; ++r) rf[r] = __builtin_amdgcn_rcpf(wb[(r & 3) + 8 * (r >> 2)]) * gb[12 * ((r & 3) + 8 * (r >> 2)) + 2];
        LDS_WAIT();
        float tp[4][16];
#pragma unroll
        for (int d = 0; d < 4; ++d)
#pragma unroll
            for (int c2 = 0; c2 < 2; ++c2) { const v4u t4 = ((const GAS v4u*)scr)[(d * 2 + c2) * 512 + tid];
                tp[d][8 * c2 + 0] = BFLO(t4.x); tp[d][8 * c2 + 1] = BFHI(t4.x); tp[d][8 * c2 + 2] = BFLO(t4.y); tp[d][8 * c2 + 3] = BFHI(t4.y);
                tp[d][8 * c2 + 4] = BFLO(t4.z); tp[d][8 * c2 + 5] = BFHI(t4.z); tp[d][8 * c2 + 6] = BFLO(t4.w); tp[d][8 * c2 + 7] = BFHI(t4.w); }
#undef BFLO
#undef BFHI
#pragma unroll
        for (int r = 0; r < 16; ++r) { bf16* orow = mix + (size_t)(t0 + 32 * qs + crow(r, hi)) * DM + 2048 + head * 128 + r32;
#pragma unroll
            for (int d = 0; d < 4; ++d) { const float v = tp[d][r] + o[d][r] * rf[r]; const float vn = dpp_xor1(v);
                if ((r32 & 1) == 0) *(unsigned*)(orow + 32 * d) = cvtpk(v, vn); } }
    }
    __syncthreads();
}
#ifndef STOP_AFTER
#define STOP_AFTER -1
#endif
#ifndef DUMP_OFF
#define DUMP_OFF 0
#endif
#ifndef REP_P0
#define REP_P0 1
#endif
#ifndef REP_P1
#define REP_P1 1
#endif
#ifndef REP_P5
#define REP_P5 1
#endif
#ifndef REP_DIFF
#define REP_DIFF 1
#endif
#ifndef REP_NSA
#define REP_NSA 1
#endif
#ifndef REP_ONLY
#define REP_ONLY 0
#endif
constexpr int ITEMS_FF = (DM / 64) * (DFF / 64), ITEMS_IN = (DM / 64) * ((NIN + 63) / 64), TAIL_UP2 = ITEMS_FF, TAIL_DN2 = ITEMS_FF, TAIL_GT2 = 5888, TAIL_DN9 = ITEMS_FF, TAIL_DN1 = ITEMS_FF, TAIL_IN1 = 0;
__device__ __forceinline__ void dbg_dump(int k, int off, float* out, const bf16* UB, const bf16* PROJ, const bf16* KC, int gw, int ngw) {
    const int ln = threadIdx.x & 63;
    if (k == 3 || k == 6) { for (size_t i = (size_t)gw * 64 + ln; i < (size_t)SEQ * DM; i += (size_t)ngw * 64) out[i] = bf2f(UB[i]); }
    else if (k == 4) { for (size_t i = (size_t)gw * 64 + ln; i < (size_t)SEQ * DM; i += (size_t)ngw * 64) { const size_t m = i / DM, n = i % DM; out[i] = bf2f(PVEC(PROJ, (off + n) & ~127)[m * 128 + ((off + n) & 127)]); } }
    else if (k == 5) { for (size_t i = (size_t)gw * 64 + ln; i < (size_t)SEQ * DM; i += (size_t)ngw * 64) out[i] = bf2f(KC[i & 524287]); }
}
struct Args { const float* in[25]; float* out; unsigned char* ws; int stop_after; int dump_off; };
__global__ void __launch_bounds__(NWAVES * 64, 2) mk_fwd(Args args) {
    extern __shared__ __attribute__((aligned(16))) unsigned char lds[];
    LAS unsigned char* ldsl = (LAS unsigned char*)lds;
    const int tid = threadIdx.x, wave = __builtin_amdgcn_readfirstlane(tid >> 6);
#define lane ((int)(threadIdx.x & 63u))
    const int G = gridDim.x, bx = blockIdx.x, vcu = (G % 8 == 0) ? (bx % 8) * (G / 8) + bx / 8 : bx;
    const int gw = vcu * NWAVES + wave, ngw = G * NWAVES;
    unsigned char* ws = args.ws;
    gu32* ctl = (gu32*)(ws + WS_CTL);
    for (int u = tid; u < (LDS_BYTES - LDSCTL_OFF) / 4; u += NWAVES * 64) ((LAS unsigned*)(ldsl + LDSCTL_OFF))[u] = 0u;
    __syncthreads();
    XcdBarrier bar = xcd_barrier_post((unsigned*)(ctl + CW_BAR), (volatile LAS unsigned*)(ldsl + MISC_OFF) + 8);
    float* h = args.out;
    bf16* UB = (bf16*)(ws + WS_UB); bf16* HID = (bf16*)(ws + WS_HID); bf16* PROJ = (bf16*)(ws + WS_HID);
    bf16* KC = (bf16*)(ws + WS_KC); bf16* VC = (bf16*)(ws + WS_VC);
    float* scr = (float*)(ws + WS_SCR) + (size_t)bx * 65536;
    const int stop = args.stop_after;
#define SEAM(k) do { xcd_barrier(bar); if (stop == (k)) { dbg_dump((k), args.dump_off, h, UB, PROJ, KC, gw, ngw); return; } } while (0)

#ifndef NO_P0
    for (int rep_ = 0; rep_ < REP_P0; ++rep_) {
        LAS float* tscr = (LAS float*)(ldsl + wave * 16640);
        tr_matrix(args.in[2], DM, DFF, (bf16*)(ws + WS_WGU1), 1, tscr, gw, ngw, lane, 2);
        tr_matrix(args.in[3], DM, DFF, (bf16*)(ws + WS_WGU1), 2, tscr, gw, ngw, lane, 2);
        tr_range(args.in[4], DFF, DM, (bf16*)(ws + WS_WD1), 0, tscr, TAIL_DN1, ITEMS_FF, gw, ngw, lane, 1);
        tr_range(args.in[6], DM, NIN, (bf16*)(ws + WS_WIN), 0, tscr, TAIL_IN1, ITEMS_IN, gw, ngw, lane, 2);
        tr_range(args.in[23], DFF, DM, (bf16*)(ws + WS_WD2), 0, tscr, TAIL_DN2, ITEMS_FF, gw, ngw, lane, 1);
        tile_w1(args.in[14], (bf16*)(ws + WS_W1K), gw, ngw, lane);
        tile_w1(args.in[17], (bf16*)(ws + WS_W1V), gw, ngw, lane);
        tr_matrix(args.in[15], 256, 128, (bf16*)(ws + WS_W2K), 0, tscr, gw, ngw, lane, 0);
        tr_matrix(args.in[18], 256, 128, (bf16*)(ws + WS_W2V), 0, tscr, gw, ngw, lane, 0);
        rms_rows_bf16(args.in[0], args.in[1], UB, gw, ngw, lane);
    }
#endif
    SEAM(0);
#ifndef NO_GEMM
    for (int rep_ = 0; rep_ < REP_P1; ++rep_) {
        pg8::Gemm g{UB, (const bf16*)(ws + WS_WGU1), SEQ, 2 * DFF, DM, 0, 1}; pg8::StaticOrder S; S.init(SEQ, 2 * DFF, G, bx);
        pg8::EpiSwiGLU E{HID, DFF, 1};
        pg8::gemm_phase<pg8::EpiSwiGLU, pg8::StaticOrder, true, true>(ldsl, g, S, E);
        { constexpr int NU = (SEQ / 256) * (2 * DFF / 256); const int nfull = NU % G;
          const int tw_ = nfull ? (bx - nfull) * NWAVES + wave : gw, tn_ = nfull ? (G - nfull) * NWAVES : ngw;
          if (rep_ == 0 && (!nfull || bx >= nfull)) { tr_range(args.in[4], DFF, DM, (bf16*)(ws + WS_WD1), 0, (LAS float*)(ldsl + wave * 16640), 0, TAIL_DN1, tw_, tn_, lane, 1);
              tr_range(args.in[6], DM, NIN, (bf16*)(ws + WS_WIN), 0, (LAS float*)(ldsl + wave * 16640), 0, TAIL_IN1, tw_, tn_, lane, 2); } }
    }
#endif
    SEAM(1);
#ifndef NO_GEMM
    {
        pg8::Gemm g{HID, (const bf16*)(ws + WS_WD1), SEQ, DM, DFF, 1, 1}; pg8::StaticOrder S; S.init(SEQ, DM, G, bx);
        pg8::EpiResF32 E{args.in[0], h, DM, 0.5f};
        pg8::gemm_phase<pg8::EpiResF32, pg8::StaticOrder, true, true>(ldsl, g, S, E);
    }
#endif
    SEAM(2);
    rms_rows_bf16(h, args.in[5], UB, gw, ngw, lane);
    SEAM(3);
#ifndef NO_GEMM
    {
        pg8::Gemm g{UB, (const bf16*)(ws + WS_WIN), SEQ, LDP, DM, 0, 1}; pg8::StaticOrder S; S.init(SEQ, LDP, G, bx);
        pg8::EpiProj E{PROJ, LDP, OFF_DQ, OFF_DK, OFF_NQ, OFF_KC, QSCALE};
        pg8::gemm_phase<pg8::EpiProj, pg8::StaticOrder, true, true>(ldsl, g, S, E);
        { constexpr int NU = (SEQ / 256) * (LDP / 256); const int nfull = NU % G;
          const int tw_ = nfull ? (bx - nfull) * NWAVES + wave : gw, tn_ = nfull ? (G - nfull) * NWAVES : ngw;
          if (!nfull || bx >= nfull) { tr_range(args.in[22], DM, DFF, (bf16*)(ws + WS_WGU2), 2, (LAS float*)(ldsl + wave * 16640), 0, TAIL_UP2, tw_, tn_, lane, 2);
              tr_range(args.in[21], DM, DFF, (bf16*)(ws + WS_WGU2), 1, (LAS float*)(ldsl + wave * 16640), TAIL_GT2, ITEMS_FF, tw_, tn_, lane, 2); } }
    }
#endif
    SEAM(4);
    norm_pass(PROJ, (float*)(ctl + CW_NORM), bx, G, (char*)lds);
    const bool split8 = (G == 256);
    const int xcd5 = bx & 7, slot5 = bx >> 3;
    const int ctask = split8 ? (slot5 < 16 ? (xcd5 >> 2) * 64 + (xcd5 & 3) * 16 + slot5 : 128) : vcu;
    const int cstep = split8 ? 128 : G;
#ifndef NO_CMP
    for (int rep_ = 0; rep_ < REP_P5; ++rep_)
    for (int task = ctask; task < 128; task += cstep) {
        const int kv = task >> 6, rb = task & 63;
        compress_task(PROJ, kv ? OFF_VC : OFF_KC, kv ? args.in[16] : args.in[13], (const bf16*)(ws + (kv ? WS_W1V : WS_W1K)), (const bf16*)(ws + (kv ? WS_W2V : WS_W2K)), kv ? VC : KC, rb,
                      (char*)lds, wave, lane);
    }
#endif
    if (split8 ? slot5 >= 16 : (vcu >= 128 || G <= 128)) {
        const int tw5_ = split8 ? ((slot5 - 16) * 8 + xcd5) * NWAVES + wave : (G > 128 ? (vcu - 128) * NWAVES + wave : gw), tn5_ = split8 ? 128 * NWAVES : (G > 128 ? (G - 128) * NWAVES : ngw);
        tr_range(args.in[23], DFF, DM, (bf16*)(ws + WS_WD2), 0, (LAS float*)(ldsl + wave * 16640), TAIL_DN9, TAIL_DN2, tw5_, tn5_, lane, 1);
        tr_range(args.in[21], DM, DFF, (bf16*)(ws + WS_WGU2), 1, (LAS float*)(ldsl + wave * 16640), 0, TAIL_GT2, tw5_, tn5_, lane, 2);
        tr_range(args.in[19], DM, DM, (bf16*)(ws + WS_WOUT), 0, (LAS float*)(ldsl + wave * 16640), 0, (DM / 64) * (DM / 64), tw5_, tn5_, lane, 1); }
    SEAM(5);
    {
        float lam;
        { const float a1 = wave_sum(args.in[8][lane] * args.in[9][lane] + args.in[8][lane + 64] * args.in[9][lane + 64]);
          const float a2 = wave_sum(args.in[10][lane] * args.in[11][lane] + args.in[10][lane + 64] * args.in[11][lane + 64]);
          lam = __expf(a1) - __expf(a2) + LAM0; }
        float* dcutL = (float*)((char*)lds + LDSCTL_OFF + 768);
        { float m = 0.f; const float* slots = (const float*)(ctl + CW_NORM);
          for (int w = tid >> 5; w < G; w += 16) m = fmaxf(m, slots[w * 32 + (tid & 31)]);
          float* red = (float*)lds; red[tid] = m; __syncthreads();
          if (tid < 32) { float mm = red[tid];
#pragma unroll
              for (int p = 1; p < 16; ++p) mm = fmaxf(mm, red[p * 32 + tid]);
              red[512 + tid] = mm; }
          __syncthreads();
          if (tid < 8) { const float qm = fmaxf(red[512 + 2 * tid], red[513 + 2 * tid]), km = fmaxf(red[528 + 2 * tid], red[529 + 2 * tid]);
              dcutL[tid] = (2.0f * qm * km + 70.0f) / (__builtin_amdgcn_exp2f(-(float)(tid + 1)) * LOG2E); }
          __syncthreads();
          unsigned char* segL = (unsigned char*)lds + LDSCTL_OFF + 512;
          float* W = (float*)((char*)lds + 4096); int* ord = (int*)((char*)lds + 4160); float* load = (float*)((char*)lds + 4224); int* ns = (int*)((char*)lds + 4256);
#pragma unroll
          for (int k = 0; k < 2; ++k) { const int s_ = 2 * wave + k, qq = lane; const float fl = ((float)(128 * qq) - dcutL[s_ >> 1]) * (1.0f / 64.0f);
              const float tot = wave_sum((float)(2 * (qq + 1) - (fl > 0.f ? (int)fl : 0)));
              if (lane == 0) W[s_] = tot; }
          __syncthreads();
          if (tid < 16) { const float me = W[tid]; int rank = 0;
              for (int j = 0; j < 16; ++j) { const float o_ = W[j]; rank += (o_ > me || (o_ == me && j < tid)) ? 1 : 0; }
              ord[rank] = tid; }
          __syncthreads();
          if (tid == 0) {
              for (int x = 0; x < 8; ++x) { load[x] = 0.f; ns[x] = 0; }
              for (int a = 0; a < 16; ++a) { int bx_ = 0; for (int x = 1; x < 8; ++x) if (load[x] < load[bx_]) bx_ = x;
                  segL[bx_ * 16 + ns[bx_]] = (unsigned char)ord[a]; ns[bx_]++; load[bx_] += W[ord[a]]; }
              for (int x = 0; x < 8; ++x) segL[128 + x] = (unsigned char)ns[x];
          }
          __syncthreads(); }
        volatile LAS unsigned* qw = (volatile LAS unsigned*)(ldsl + MISC_OFF) + 12;
        const int myx = (int)(xb_xcc_id() & 7u);
        for (int rep_ = 0; rep_ < REP_DIFF; ++rep_) {
#pragma unroll 1
        for (int dx = 0; dx < 8; ++dx) {
            const int x = (myx + dx) & 7;
            const int nsg = __builtin_amdgcn_readfirstlane((int)((unsigned char*)lds + LDSCTL_OFF + 512)[128 + x]), len = 64 * nsg + 64;
#pragma unroll 1
            for (;;) {
                if (tid == 0) qw[0] = __hip_atomic_fetch_add((unsigned*)(ctl + CW_QUEUE) + 64 * (8 * rep_ + x), 1u, __ATOMIC_RELAXED, __HIP_MEMORY_SCOPE_AGENT);
                __syncthreads();
                const int u = __builtin_amdgcn_readfirstlane((int)qw[0]);
                __syncthreads();
                if (u >= len) break;
                if (u >= 64) {
#ifndef NO_DIFF
                    if (rep_ >= 1 && (REP_ONLY == 2 || REP_ONLY >= 64)) continue;
                    const int st = __builtin_amdgcn_readfirstlane((int)((unsigned char*)lds + LDSCTL_OFF + 512)[x * 16 + ((u - 64) >> 6)]), hh = st >> 1, qt = 63 - (u & 63);
                    const float fl = ((float)(128 * qt) - dcutL[hh]) * (1.0f / 64.0f);
                    const int jlo = __builtin_amdgcn_readfirstlane(fl > 0.f ? (int)fl : 0);
                    diff_job(PROJ, UB, (float*)(ws + WS_DPART), (unsigned*)(ctl + CW_DCNT) + 32768 * rep_, args.in[12], lam, hh, qt, st & 1, jlo, (char*)lds, qw, (rep_ >= 1 && REP_ONLY >= 3) ? REP_ONLY - 2 : 0);
#endif
                } else {
#ifndef NO_NSA
                    if (rep_ >= 1 && (REP_ONLY == 1 || (REP_ONLY >= 3 && REP_ONLY < 64))) continue;
                    const int j = u;
                    nsa_unit(PROJ, KC, VC, UB, scr, args.in[7], x >> 1, 127 - 2 * j - (x & 1), (char*)lds, (rep_ >= 1 && REP_ONLY >= 64) ? REP_ONLY - 64 : 0);
#endif
                }
            }
        } }
    }
    SEAM(6);
#ifndef NO_GEMM
    {
        pg8::Gemm g{UB, (const bf16*)(ws + WS_WOUT), SEQ, DM, DM, 0, 1}; pg8::StaticOrder S; S.init(SEQ, DM, G, bx);
        pg8::EpiResF32 E{h, h, DM, 1.0f};
        pg8::gemm_phase<pg8::EpiResF32, pg8::StaticOrder, true, true>(ldsl, g, S, E);
    }
#endif
    SEAM(7);
    rms_rows_bf16(h, args.in[20], UB, gw, ngw, lane);
    SEAM(8);
#ifndef NO_GEMM
    {
        pg8::Gemm g{UB, (const bf16*)(ws + WS_WGU2), SEQ, 2 * DFF, DM, 0, 1}; pg8::StaticOrder S; S.init(SEQ, 2 * DFF, G, bx);
        pg8::EpiSwiGLU E{HID, DFF, 1};
        pg8::gemm_phase<pg8::EpiSwiGLU, pg8::StaticOrder, true, true>(ldsl, g, S, E);
        { constexpr int NU = (SEQ / 256) * (2 * DFF / 256); const int nfull = NU % G;
          const int tw_ = nfull ? (bx - nfull) * NWAVES + wave : gw, tn_ = nfull ? (G - nfull) * NWAVES : ngw;
          if (!nfull || bx >= nfull) tr_range(args.in[23], DFF, DM, (bf16*)(ws + WS_WD2), 0, (LAS float*)(ldsl + wave * 16640), 0, TAIL_DN9, tw_, tn_, lane, 1); }
    }
#endif
    SEAM(9);
#ifndef NO_GEMM
    {
        pg8::Gemm g{HID, (const bf16*)(ws + WS_WD2), SEQ, DM, DFF, 1, 1}; pg8::StaticOrder S; S.init(SEQ, DM, G, bx);
        pg8::EpiResF32 E{h, h, DM, 0.5f};
        pg8::gemm_phase<pg8::EpiResF32, pg8::StaticOrder, true, true>(ldsl, g, S, E);
    }
#endif
    SEAM(10);
    rms_rows_f32(h, args.in[24], gw, ngw, lane);
#undef SEAM
#undef lane
}

extern "C" void kernel_launch(void* const* d_in, const int* in_sizes, int n_in, void* d_out, int out_size, void* d_ws, size_t ws_size, hipStream_t stream) {
    static int grid = 0;
    if (grid == 0) {
        if (n_in != 25 || in_sizes[0] != SEQ * DM || out_size != SEQ * DM || ws_size < WS_END) {
            fprintf(stderr, "kernel_launch: built for 25 inputs, x/out of %d floats, >= %zu bytes of workspace; got n_in %d, in0 %d, out %d, ws %zu; nothing launched\n", SEQ * DM, (size_t)WS_END, n_in, n_in > 0 ? in_sizes[0] : -1, out_size, ws_size);
            grid = -1; return; }
        int dev = 0, cus = 0, per_cu = 0;
        if (hipGetDevice(&dev) != hipSuccess || hipDeviceGetAttribute(&cus, hipDeviceAttributeMultiprocessorCount, dev) != hipSuccess) { fprintf(stderr, "kernel_launch: device query failed\n"); grid = -1; return; }
        if (hipFuncSetAttribute((const void*)mk_fwd, hipFuncAttributeMaxDynamicSharedMemorySize, LDS_BYTES) != hipSuccess) { fprintf(stderr, "kernel_launch: hipFuncSetAttribute failed\n"); grid = -1; return; }
        if (hipOccupancyMaxActiveBlocksPerMultiprocessor(&per_cu, (const void*)mk_fwd, NWAVES * 64, LDS_BYTES) != hipSuccess || per_cu < 1)
            fprintf(stderr, "kernel_launch: note: occupancy query reports %d workgroups per CU\n", per_cu);
        (void)hipGetLastError();
        grid = cus;
    }
    if (grid < 0) return;
    if (hipMemsetAsync((char*)d_ws + WS_CTL, 0, CTL_ZERO_BYTES, stream) != hipSuccess) { fprintf(stderr, "kernel_launch: memset failed\n"); return; }
    Args a{};
    for (int i = 0; i < 25; ++i) a.in[i] = (const float*)d_in[i];
    a.out = (float*)d_out; a.ws = (unsigned char*)d_ws; a.stop_after = STOP_AFTER; a.dump_off = DUMP_OFF;
    hipLaunchKernelGGL(mk_fwd, dim3(grid), dim3(NWAVES * 64), LDS_BYTES, stream, a);
    const hipError_t le = hipPeekAtLastError();
    if (le != hipSuccess) fprintf(stderr, "kernel_launch: launch failed: %s\n", hipGetErrorName(le));
}
```
